# Optimizing an MI355X kernel written in HIP

```python
import math
import jax, jax.numpy as jnp
from jax import lax
import numpy as np

D_MODEL = 1024
BATCH = 8
SEQ = 2048
DEPTH = 2

N_MIXERS = 2
N_RET_LAYERS = (DEPTH + 1) // 2
N_MLA_LAYERS = DEPTH // 2
DN_ALPHA = (2.0 * DEPTH) ** 0.25
DN_BETA = (8.0 * DEPTH) ** -0.25
LN_EPS = 1e-5
ROPE_BASE = 10000.0

RET_HEADS = 4
RET_DK = D_MODEL // RET_HEADS
RET_DV = 2 * RET_DK
RET_HK = RET_HEADS * RET_DK
RET_HV = RET_HEADS * RET_DV
RET_IN = 2 * RET_HK + 2 * RET_HV
RET_CHUNK = 128

MLA_HEADS = 8
MLA_NOPE = 128
MLA_ROPE = 64
MLA_VDIM = 128
MLA_Q_RANK = 384
MLA_KV_RANK = 256
MLA_IN = MLA_Q_RANK + MLA_KV_RANK + MLA_ROPE
MLA_QBLOCK = 128

PEER_HEADS = 8
PEER_NKEYS = 128
PEER_EXPERTS = PEER_NKEYS * PEER_NKEYS
PEER_DKEY = 256
PEER_HALF = PEER_DKEY // 2
PEER_TOPK = 16
PEER_TOKEN_BLOCK = 128

kernel_name = 'hybrid_retention_mla_peer_deepnorm'


def layer_norm(x, g, b):
    xf = x.astype(jnp.float32)
    mu = jnp.mean(xf, axis=-1, keepdims=True)
    var = jnp.mean(jnp.square(xf - mu), axis=-1, keepdims=True)
    return ((xf - mu) * lax.rsqrt(var + LN_EPS) * g.astype(jnp.float32) + b.astype(jnp.float32)).astype(x.dtype)


def rms_norm(x, g):
    xf = x.astype(jnp.float32)
    ms = jnp.mean(jnp.square(xf), axis=-1, keepdims=True)
    return (xf * lax.rsqrt(ms + LN_EPS) * g.astype(jnp.float32)).astype(x.dtype)


def rotary(x, positions):
    d = x.shape[-1]
    inv_freq = ROPE_BASE ** (-jnp.arange(0, d, 2, dtype=jnp.float32) / d)
    ang = positions.astype(jnp.float32)[..., None] * inv_freq
    cos = jnp.cos(ang)[:, :, None, :]
    sin = jnp.sin(ang)[:, :, None, :]
    x1, x2 = jnp.split(x.astype(jnp.float32), 2, axis=-1)
    return jnp.concatenate([x1 * cos - x2 * sin, x1 * sin + x2 * cos], axis=-1).astype(x.dtype)


def retention_scan(q, k, v, log_gamma, strict):
    B, S, H, dk = q.shape
    dv = v.shape[-1]
    C = RET_CHUNK
    n_chunks = S // C
    dt = q.dtype
    idx = jnp.arange(C, dtype=jnp.float32)
    diff = idx[:, None] - idx[None, :]
    keep = (diff > 0) if strict else (diff >= 0)
    lg = log_gamma[:, None, None]
    decay = jnp.where(keep[None], jnp.exp(jnp.maximum(diff, 0.0)[None] * lg), 0.0).astype(dt)
    xi = jnp.exp((idx + 1.0)[None, :] * log_gamma[:, None]).astype(dt)
    zeta = jnp.exp((C - 1.0 - idx)[None, :] * log_gamma[:, None]).astype(dt)
    gamma_c = jnp.exp(C * log_gamma).astype(dt)[None, :, None, None]

    def to_chunks(t):
        return t.reshape(B, n_chunks, C, H, t.shape[-1]).transpose(1, 0, 3, 2, 4)

    def step(state, inp):
        qi, ki, vi = inp
        inner = jnp.einsum('bhnm,bhmv->bhnv', jnp.einsum('bhnd,bhmd->bhnm', qi, ki) * decay[None], vi)
        cross = jnp.einsum('bhnd,bhdv->bhnv', qi, state) * xi[None, :, :, None]
        state = gamma_c * state + jnp.einsum('bhmd,bhmv->bhdv', ki * zeta[None, :, :, None], vi)
        return state, inner + cross

    state0 = jnp.zeros((B, H, dk, dv), dt)
    _, out = lax.scan(step, state0, (to_chunks(q), to_chunks(k), to_chunks(v)))
    return out.transpose(1, 0, 3, 2, 4).reshape(B, S, H, dv)


def retention_mixer(x, positions, w_in, log1m_decay, gn_g, gn_b, w_out):
    B, S, _ = x.shape
    proj = x @ w_in
    q, k, v, g = jnp.split(proj, [RET_HK, 2 * RET_HK, 2 * RET_HK + RET_HV], axis=-1)
    q = rotary(q.reshape(B, S, RET_HEADS, RET_DK), positions)
    k = rotary(k.reshape(B, S, RET_HEADS, RET_DK), positions) * (RET_DK ** -0.5)
    v = v.reshape(B, S, RET_HEADS, RET_DV)
    log_gamma = jnp.log1p(-jnp.exp(log1m_decay.astype(jnp.float32)))
    fwd = retention_scan(q, k, v, log_gamma[0], strict=False)
    bwd = jnp.flip(retention_scan(jnp.flip(q, 1), jnp.flip(k, 1), jnp.flip(v, 1), log_gamma[1], strict=True), 1)
    y = (fwd + bwd).astype(jnp.float32)
    mu = jnp.mean(y, axis=-1, keepdims=True)
    var = jnp.mean(jnp.square(y - mu), axis=-1, keepdims=True)
    yn = ((y - mu) * lax.rsqrt(var + LN_EPS)).reshape(B, S, RET_HV)
    yn = (yn * gn_g.astype(jnp.float32) + gn_b.astype(jnp.float32)).astype(x.dtype)
    return (jax.nn.silu(g) * yn) @ w_out


def mla_mixer(x, positions, w_in, q_norm_g, kv_norm_g, w_uq, w_ukv, w_out):
    B, S, _ = x.shape
    c_q, c_kv, k_rope = jnp.split(x @ w_in, [MLA_Q_RANK, MLA_Q_RANK + MLA_KV_RANK], axis=-1)
    q = (rms_norm(c_q, q_norm_g) @ w_uq).reshape(B, S, MLA_HEADS, MLA_NOPE + MLA_ROPE)
    q_nope, q_rope = jnp.split(q, [MLA_NOPE], axis=-1)
    q_rope = rotary(q_rope, positions)
    kv = (rms_norm(c_kv, kv_norm_g) @ w_ukv).reshape(B, S, MLA_HEADS, MLA_NOPE + MLA_VDIM)
    k_nope, v = jnp.split(kv, [MLA_NOPE], axis=-1)
    k_rope = rotary(k_rope[:, :, None, :], positions)[:, :, 0, :]
    scale = (MLA_NOPE + MLA_ROPE) ** -0.5
    nb = S // MLA_QBLOCK

    def blocks(t):
        return t.reshape(B, nb, MLA_QBLOCK, MLA_HEADS, t.shape[-1]).transpose(1, 0, 2, 3, 4)

    def attend(blk):
        qn, qr = blk
        s = jnp.einsum('bqhd,bkhd->bhqk', qn, k_nope) + jnp.einsum('bqhd,bkd->bhqk', qr, k_rope)
        p = jax.nn.softmax(s.astype(jnp.float32) * scale, axis=-1).astype(v.dtype)
        return jnp.einsum('bhqk,bkhd->bqhd', p, v)

    o = lax.map(attend, (blocks(q_nope), blocks(q_rope)))
    o = o.transpose(1, 0, 2, 3, 4).reshape(B, S, MLA_HEADS * MLA_VDIM)
    return o @ w_out


def peer_ffn(x, w_q, sub_keys, u, v):
    B, S, D = x.shape
    T = B * S
    xt = x.reshape(T // PEER_TOKEN_BLOCK, PEER_TOKEN_BLOCK, D)

    def block(xb):
        q = (xb @ w_q).reshape(PEER_TOKEN_BLOCK, PEER_HEADS, 2, PEER_HALF)
        s = jnp.einsum('thcd,hckd->thck', q, sub_keys).astype(jnp.float32)
        s1, i1 = lax.top_k(s[:, :, 0], PEER_TOPK)
        s2, i2 = lax.top_k(s[:, :, 1], PEER_TOPK)
        cand_s = (s1[..., :, None] + s2[..., None, :]).reshape(PEER_TOKEN_BLOCK, PEER_HEADS, PEER_TOPK * PEER_TOPK)
        cand_i = (i1[..., :, None] * PEER_NKEYS + i2[..., None, :]).reshape(PEER_TOKEN_BLOCK, PEER_HEADS, PEER_TOPK * PEER_TOPK)
        top_s, pos = lax.top_k(cand_s, PEER_TOPK)
        eidx = jnp.take_along_axis(cand_i, pos, axis=-1)
        gate = jax.nn.softmax(top_s, axis=-1).astype(xb.dtype)
        h = jax.nn.gelu(jnp.einsum('thkd,td->thk', u[eidx], xb), approximate=False)
        return jnp.einsum('thk,thkd->td', gate * h, v[eidx])

    return lax.map(block, xt).reshape(B, S, D)


def setup_inputs(seed: int = 0) -> dict:
    key = jax.random.key(seed)
    ks = jax.random.split(key, 24)
    f32 = jnp.float32
    nrm = lambda k, shape, s: jax.random.normal(k, shape, f32) * s
    x = jax.random.normal(ks[0], (BATCH, SEQ, D_MODEL), f32)
    offsets = jax.random.randint(ks[1], (BATCH, 1), 0, 512, dtype=jnp.int32)
    positions = (offsets + jnp.arange(SEQ, dtype=jnp.int32)[None, :]).astype(jnp.int32)
    ret_w_in = nrm(ks[2], (N_RET_LAYERS, D_MODEL, RET_IN), D_MODEL ** -0.5)
    base = (-5.0 - jnp.arange(RET_HEADS, dtype=f32)) * math.log(2.0)
    ret_log1m_decay = base[None, None, :] + nrm(ks[3], (N_RET_LAYERS, 2, RET_HEADS), 0.05)
    ret_gn_g = 1.0 + nrm(ks[4], (N_RET_LAYERS, RET_HV), 0.02)
    ret_gn_b = nrm(ks[5], (N_RET_LAYERS, RET_HV), 0.02)
    ret_w_out = nrm(ks[6], (N_RET_LAYERS, RET_HV, D_MODEL), DN_BETA * RET_HV ** -0.5)
    mla_w_in = nrm(ks[7], (N_MLA_LAYERS, D_MODEL, MLA_IN), D_MODEL ** -0.5)
    mla_q_norm = 1.0 + nrm(ks[8], (N_MLA_LAYERS, MLA_Q_RANK), 0.02)
    mla_kv_norm = 1.0 + nrm(ks[9], (N_MLA_LAYERS, MLA_KV_RANK), 0.02)
    mla_w_uq = nrm(ks[10], (N_MLA_LAYERS, MLA_Q_RANK, MLA_HEADS * (MLA_NOPE + MLA_ROPE)), MLA_Q_RANK ** -0.5)
    mla_w_ukv = nrm(ks[11], (N_MLA_LAYERS, MLA_KV_RANK, MLA_HEADS * (MLA_NOPE + MLA_VDIM)), MLA_KV_RANK ** -0.5)
    mla_w_out = nrm(ks[12], (N_MLA_LAYERS, MLA_HEADS * MLA_VDIM, D_MODEL), DN_BETA * (MLA_HEADS * MLA_VDIM) ** -0.5)
    peer_w_q = nrm(ks[13], (DEPTH, D_MODEL, PEER_HEADS * PEER_DKEY), D_MODEL ** -0.5)
    peer_sub_keys = nrm(ks[14], (DEPTH, PEER_HEADS, 2, PEER_NKEYS, PEER_HALF), PEER_HALF ** -0.5)
    peer_u = nrm(ks[15], (DEPTH, PEER_EXPERTS, D_MODEL), D_MODEL ** -0.5)
    peer_v = nrm(ks[16], (DEPTH, PEER_EXPERTS, D_MODEL), DN_BETA * (PEER_HEADS * PEER_TOPK) ** -0.5)
    ln_mix_g = 1.0 + nrm(ks[17], (DEPTH, D_MODEL), 0.02)
    ln_mix_b = nrm(ks[18], (DEPTH, D_MODEL), 0.02)
    ln_ffn_g = 1.0 + nrm(ks[19], (DEPTH, D_MODEL), 0.02)
    ln_ffn_b = nrm(ks[20], (DEPTH, D_MODEL), 0.02)
    return {'x': x, 'positions': positions,
            'ret_w_in': ret_w_in, 'ret_log1m_decay': ret_log1m_decay, 'ret_gn_g': ret_gn_g, 'ret_gn_b': ret_gn_b, 'ret_w_out': ret_w_out,
            'mla_w_in': mla_w_in, 'mla_q_norm': mla_q_norm, 'mla_kv_norm': mla_kv_norm, 'mla_w_uq': mla_w_uq, 'mla_w_ukv': mla_w_ukv, 'mla_w_out': mla_w_out,
            'peer_w_q': peer_w_q, 'peer_sub_keys': peer_sub_keys, 'peer_u': peer_u, 'peer_v': peer_v,
            'ln_mix_g': ln_mix_g, 'ln_mix_b': ln_mix_b, 'ln_ffn_g': ln_ffn_g, 'ln_ffn_b': ln_ffn_b}


def reference(x, positions,
              ret_w_in, ret_log1m_decay, ret_gn_g, ret_gn_b, ret_w_out,
              mla_w_in, mla_q_norm, mla_kv_norm, mla_w_uq, mla_w_ukv, mla_w_out,
              peer_w_q, peer_sub_keys, peer_u, peer_v,
              ln_mix_g, ln_mix_b, ln_ffn_g, ln_ffn_b):
    h = x
    for i in range(DEPTH):
        j = i // N_MIXERS
        if i % N_MIXERS == 0:
            mix = retention_mixer(h, positions, ret_w_in[j], ret_log1m_decay[j], ret_gn_g[j], ret_gn_b[j], ret_w_out[j])
        else:
            mix = mla_mixer(h, positions, mla_w_in[j], mla_q_norm[j], mla_kv_norm[j], mla_w_uq[j], mla_w_ukv[j], mla_w_out[j])
        h = layer_norm(DN_ALPHA * h + mix, ln_mix_g[i], ln_mix_b[i])
        ffn = peer_ffn(h, peer_w_q[i], peer_sub_keys[i], peer_u[i], peer_v[i])
        h = layer_norm(DN_ALPHA * h + ffn, ln_ffn_g[i], ln_ffn_b[i])
    return h
```

```cpp
#include <hip/hip_runtime.h>
#include <cstdio>
#include <cstdint>
#include <cmath>
namespace pg8 {
#define PG8_LAS __attribute__((address_space(3)))
typedef unsigned short bf16_t;
typedef short bf16x8 __attribute__((ext_vector_type(8)));
typedef float f32x4 __attribute__((ext_vector_type(4)));
typedef unsigned u32x4 __attribute__((ext_vector_type(4)));
constexpr int BM = 256, BK = 64, HALF = 128, HTB = HALF * BK * 2  , STAGE_BYTES = 8 * HTB, NXCD = 8, WGM = 8;

__host__ __device__ __forceinline__ int lds_byte(int r, int c) { const int st = (r >> 4) * 2 + (c >> 5), rr = r & 15, cc = c & 31, ob = rr * 64 + cc * 2; return st * 1024 + (ob ^ (((ob >> 9) & 1) << 5)); }
__host__ __device__ __forceinline__ void stage_rc(int b, int& R, int& C) { const int st = b / 1024, sb = b % 1024, swz = sb ^ (((sb >> 9) & 1) << 5); R = (st >> 1) * 16 + swz / 64; C = (st & 1) * 32 + (swz % 64) / 2; }
__host__ __device__ __forceinline__ int perm32(int rho) { const int n = rho >> 4, i = rho & 15; return 8 * (i >> 2) + 4 * n + (i & 3); }

struct Unit { int pm, pn; };
struct Gemm { const bf16_t* A; const bf16_t* Bt; int M, N, K; };

struct StaticOrder {
    int nM, nN, nwg, G, c;
    __host__ __device__ void init(int M, int N, int G_, int c_) { nM = M / BM; nN = N / BM; nwg = nM * nN; G = G_; c = c_; }
    __host__ __device__ bool next(int i, Unit& u) const {
        const long L = (long)i * G + c; if (L >= nwg) return false;
        int wgid = (int)L; { const int q = nwg / NXCD, r = nwg % NXCD, xcd = wgid % NXCD, off = wgid / NXCD; wgid = (xcd < r ? xcd * (q + 1) : r * (q + 1) + (xcd - r) * q) + off; }
        const int nig = WGM * nN, gid = wgid / nig, fm = gid * WGM, gsz = (nM - fm) < WGM ? (nM - fm) : WGM;
        u.pm = fm + ((wgid % nig) % gsz); u.pn = (wgid % nig) / gsz; return true;
    }
    __device__ __forceinline__ void a_ready(const Unit&) const {}
    __device__ __forceinline__ void done(const Unit&) const {}
};

typedef float f32x2_cv __attribute__((ext_vector_type(2))); typedef __bf16 bf16x2_cv __attribute__((ext_vector_type(2)));
__device__ __forceinline__ unsigned cvt_pk_bf16(float lo, float hi) { f32x2_cv v = {lo, hi}; bf16x2_cv b = __builtin_convertvector(v, bf16x2_cv); return __builtin_bit_cast(unsigned, b); }
typedef float f32x2 __attribute__((ext_vector_type(2)));
__device__ __forceinline__ u32x4 pack8(const f32x4 a, const f32x4 b, float sc) {
    u32x4 w; w.x = cvt_pk_bf16(a[0] * sc, a[1] * sc); w.y = cvt_pk_bf16(a[2] * sc, a[3] * sc); w.z = cvt_pk_bf16(b[0] * sc, b[1] * sc); w.w = cvt_pk_bf16(b[2] * sc, b[3] * sc); return w;
}
struct EpiRetIn {
    static constexpr bool PERM = true, AFTER_DRAIN = false;
    bf16_t *Q, *Kb, *V, *G; const int* pos;
    __device__ __forceinline__ void operator()(const f32x4 (&acc)[2][2][4][2], const Unit& u, int wr, int wc, int fr, int fq) const {
        const int row0 = u.pm * BM + wr * 64 + fr;
        if (u.pn < 8) {
            bf16_t* base = (u.pn < 4) ? Q : Kb; const int head = u.pn & 3; const float sc = (u.pn < 4) ? 1.0f : 0.0625f;
            const int i0 = wc * 32 + 8 * fq;
            float fv[8];
#pragma unroll
            for (int j = 0; j < 8; ++j) fv[j] = __builtin_amdgcn_exp2f(-(float)(i0 + j) * (13.287712379549449f / 128.0f)) * 0.15915494309189535f;
#pragma unroll
            for (int ai = 0; ai < 2; ++ai)
#pragma unroll
                for (int m = 0; m < 4; ++m) {
                    const int row = row0 + ai * HALF + m * 16; const float p = (float)pos[row];
                    f32x4 o1[2], o2[2];
#pragma unroll
                    for (int n = 0; n < 2; ++n)
#pragma unroll
                        for (int e = 0; e < 4; ++e) {
                            float a = p * fv[4 * n + e]; a = __builtin_amdgcn_fractf(a);
                            const float s = __builtin_amdgcn_sinf(a), c = __builtin_amdgcn_cosf(a);
                            const float x1 = acc[ai][0][m][n][e], x2 = acc[ai][1][m][n][e];
                            o1[n][e] = x1 * c - x2 * s; o2[n][e] = x1 * s + x2 * c;
                        }
                    bf16_t* rp = base + (size_t)row * 1024 + head * 256 + i0;
                    *(u32x4*)rp = pack8(o1[0], o1[1], sc); *(u32x4*)(rp + 128) = pack8(o2[0], o2[1], sc);
                    asm volatile("" ::: "memory");
                }
        } else {
            bf16_t* base = (u.pn < 16) ? V : G; const int ct = (u.pn < 16) ? u.pn - 8 : u.pn - 16;
            const int col0 = ct * BM + wc * 32 + 8 * fq;
#pragma unroll
            for (int ai = 0; ai < 2; ++ai)
#pragma unroll
                for (int m = 0; m < 4; ++m) {
                    bf16_t* rp = base + (size_t)(row0 + ai * HALF + m * 16) * 2048 + col0;
#pragma unroll
                    for (int bj = 0; bj < 2; ++bj) *(u32x4*)(rp + bj * HALF) = pack8(acc[ai][bj][m][0], acc[ai][bj][m][1], 1.0f);
                }
        }
    }
};
struct EpiRes {
    static constexpr bool PERM = true, AFTER_DRAIN = false;
    const float* base; float* out; float alpha; float mixs;
    __device__ __forceinline__ void operator()(const f32x4 (&acc)[2][2][4][2], const Unit& u, int wr, int wc, int fr, int fq) const {
        const int row0 = u.pm * BM + wr * 64 + fr, col0 = u.pn * BM + wc * 32 + 8 * fq;
#pragma unroll
        for (int ai = 0; ai < 2; ++ai)
#pragma unroll
            for (int m = 0; m < 4; ++m) {
                const size_t off = (size_t)(row0 + ai * HALF + m * 16) * 1024 + col0;
#pragma unroll
                for (int bj = 0; bj < 2; ++bj)
#pragma unroll
                    for (int n = 0; n < 2; ++n) { const f32x4 b = *(const f32x4*)(base + off + bj * HALF + 4 * n); *(f32x4*)(out + off + bj * HALF + 4 * n) = b * alpha + acc[ai][bj][m][n] * mixs; }
            }
    }
};
struct EpiF32 {
    static constexpr bool PERM = true, AFTER_DRAIN = false;
    float* C; int ldc;
    __device__ __forceinline__ void operator()(const f32x4 (&acc)[2][2][4][2], const Unit& u, int wr, int wc, int fr, int fq) const {
        const int row0 = u.pm * BM + wr * 64 + fr, col0 = u.pn * BM + wc * 32 + 8 * fq;
#pragma unroll
        for (int ai = 0; ai < 2; ++ai)
#pragma unroll
            for (int m = 0; m < 4; ++m) {
                const size_t off = (size_t)(row0 + ai * HALF + m * 16) * ldc + col0;
#pragma unroll
                for (int bj = 0; bj < 2; ++bj)
#pragma unroll
                    for (int n = 0; n < 2; ++n) *(f32x4*)(C + off + bj * HALF + 4 * n) = acc[ai][bj][m][n];
            }
    }
};
struct EpiBf {
    static constexpr bool PERM = true, AFTER_DRAIN = false;
    bf16_t* O; int ldc;
    __device__ __forceinline__ void operator()(const f32x4 (&acc)[2][2][4][2], const Unit& u, int wr, int wc, int fr, int fq) const {
        const int row0 = u.pm * BM + wr * 64 + fr, col0 = u.pn * BM + wc * 32 + 8 * fq;
#pragma unroll
        for (int ai = 0; ai < 2; ++ai)
#pragma unroll
            for (int m = 0; m < 4; ++m) {
                bf16_t* rp = O + (size_t)(row0 + ai * HALF + m * 16) * ldc + col0;
#pragma unroll
                for (int bj = 0; bj < 2; ++bj) *(u32x4*)(rp + bj * HALF) = pack8(acc[ai][bj][m][0], acc[ai][bj][m][1], 1.0f);
            }
    }
};
struct EpiUq {
    static constexpr bool PERM = true, AFTER_DRAIN = false;
    bf16_t* O; const int* pos; float qs;
    __device__ __forceinline__ void operator()(const f32x4 (&acc)[2][2][4][2], const Unit& u, int wr, int wc, int fr, int fq) const {
        const int row0 = u.pm * BM + wr * 64 + fr, col0 = u.pn * BM + wc * 32 + 8 * fq;
        if (u.pn < 4) {
#pragma unroll
            for (int ai = 0; ai < 2; ++ai)
#pragma unroll
                for (int m = 0; m < 4; ++m) {
                    bf16_t* rp = O + (size_t)(row0 + ai * HALF + m * 16) * 1536 + col0;
#pragma unroll
                    for (int bj = 0; bj < 2; ++bj) *(u32x4*)(rp + bj * HALF) = pack8(acc[ai][bj][m][0], acc[ai][bj][m][1], qs);
                }
        } else {
            float fv[8];
#pragma unroll
            for (int j = 0; j < 8; ++j) fv[j] = __builtin_amdgcn_exp2f(-(float)(8 * fq + j) * (13.287712379549449f / 32.0f)) * 0.15915494309189535f;
#pragma unroll
            for (int ai = 0; ai < 2; ++ai)
#pragma unroll
                for (int m = 0; m < 4; ++m) {
                    const int row = row0 + ai * HALF + m * 16; const float p = (float)pos[row];
                    f32x4 o1[2], o2[2];
#pragma unroll
                    for (int n = 0; n < 2; ++n)
#pragma unroll
                        for (int e = 0; e < 4; ++e) {
                            float a = p * fv[4 * n + e]; a = __builtin_amdgcn_fractf(a);
                            const float s = __builtin_amdgcn_sinf(a), c = __builtin_amdgcn_cosf(a);
                            const float x1 = acc[ai][0][m][n][e], x2 = acc[ai][1][m][n][e];
                            o1[n][e] = x1 * c - x2 * s; o2[n][e] = x1 * s + x2 * c;
                        }
                    bf16_t* rp = O + (size_t)row * 1536 + col0;
                    *(u32x4*)rp = pack8(o1[0], o1[1], qs); *(u32x4*)(rp + 128) = pack8(o2[0], o2[1], qs);
                    asm volatile("" ::: "memory");
                }
        }
    }
};
template <class Epi, class Sched, bool ALIGN_EPI = false, bool SP2 = false>
__device__ __forceinline__ void gemm_phase(PG8_LAS unsigned char* lds, const Gemm g, const Sched& S, const Epi& E) {
    const int tid = threadIdx.x, wid = __builtin_amdgcn_readfirstlane(tid >> 6), lane = tid & 63, wr = wid >> 2, wc = wid & 3, fr = lane & 15, fq = lane >> 4;
    const int K = g.K, nt = K / BK;
    unsigned voffA[2], voffB[2];
#pragma unroll
    for (int i = 0; i < 2; ++i) { int R, C; stage_rc(tid * 16 + i * 8192, R, C); const int Rb = Epi::PERM ? ((R & ~31) + perm32(R & 31)) : R;
        voffA[i] = (unsigned)(R * K + C) * 2u; voffB[i] = (unsigned)(Rb * K + C) * 2u; }
    const size_t kstep = (size_t)(BK * 2);
    const size_t hstep = (size_t)HALF * K * 2;
    const size_t tstep = 2 * hstep;
    const unsigned ldsw = (unsigned)wid * 1024u;
    const int aoff = lds_byte(wr * 64 + fr, fq * 8), boff = lds_byte(wc * 32 + fr, fq * 8);
#define PG8_SA(b, h) (((b) * 2 + (h)) * HTB)
#define PG8_SB(b, h) ((4 + (b) * 2 + (h)) * HTB)
#define PG8_STAGE(bufoff, gbase, voff) do { _Pragma("unroll") for (int _i = 0; _i < 2; ++_i) \
        __builtin_amdgcn_global_load_lds((const unsigned*)((const char*)(gbase) + (voff)[_i]), (PG8_LAS unsigned*)(lds + (bufoff) + ldsw + _i * 8192), 16, 0, 0); } while (0)
#define PG8_LDA(dst, b, h) do { _Pragma("unroll") for (int m = 0; m < 4; ++m) _Pragma("unroll") for (int k = 0; k < 2; ++k) dst[m][k] = *(const PG8_LAS bf16x8*)(lds + PG8_SA(b, h) + aoff + m * 2048 + k * 1024); } while (0)
#define PG8_LDB(dst, b, h) do { _Pragma("unroll") for (int n = 0; n < 2; ++n) _Pragma("unroll") for (int k = 0; k < 2; ++k) dst[n][k] = *(const PG8_LAS bf16x8*)(lds + PG8_SB(b, h) + boff + n * 2048 + k * 1024); } while (0)
#define PG8_MMA(ai, bj, At, Bt) do { __builtin_amdgcn_s_setprio(1); _Pragma("unroll") for (int m = 0; m < 4; ++m) _Pragma("unroll") for (int n = 0; n < 2; ++n) _Pragma("unroll") for (int k = 0; k < 2; ++k) \
        acc[ai][bj][m][n] = __builtin_amdgcn_mfma_f32_16x16x32_bf16(Bt[n][k], At[m][k], acc[ai][bj][m][n], 0, 0, 0); __builtin_amdgcn_s_setprio(0); } while (0)
#define PG8_WAIT_V(n) asm volatile("s_waitcnt vmcnt(" #n ")" ::: "memory")
#define PG8_WAIT_L(n) asm volatile("s_waitcnt lgkmcnt(" #n ")" ::: "memory")
#define PG8_BAR __builtin_amdgcn_s_barrier()
#define PG8_SCHED __builtin_amdgcn_sched_barrier(0)
    Unit cur, nxt; int ui = 0;
    if (!S.next(0, cur)) return;
    f32x4 acc[2][2][4][2];
#pragma unroll
    for (int a = 0; a < 2; ++a)
#pragma unroll
        for (int b = 0; b < 2; ++b)
#pragma unroll
            for (int m = 0; m < 4; ++m)
#pragma unroll
                for (int n = 0; n < 2; ++n) acc[a][b][m][n] = (f32x4){0.f, 0.f, 0.f, 0.f};
    bf16x8 At[4][2], B0[2][2], B1[2][2];
    const char* cA = (const char*)g.A + (size_t)cur.pm * tstep; const char* cB = (const char*)g.Bt + (size_t)cur.pn * tstep;
    S.a_ready(cur);
    if constexpr (SP2) {
        PG8_STAGE(PG8_SB(0, 0), cB, voffB); PG8_STAGE(PG8_SB(0, 1), cB + hstep, voffB); PG8_STAGE(PG8_SA(0, 0), cA, voffA); PG8_STAGE(PG8_SA(0, 1), cA + hstep, voffA);
        if (wr == 1) PG8_BAR;
        PG8_WAIT_V(2); PG8_BAR;
        PG8_STAGE(PG8_SB(1, 0), cB + kstep, voffB); PG8_STAGE(PG8_SA(1, 0), cA + kstep, voffA); PG8_STAGE(PG8_SB(1, 1), cB + hstep + kstep, voffB);
        PG8_WAIT_V(6); PG8_BAR;
    } else {
        PG8_STAGE(PG8_SB(0, 0), cB, voffB); PG8_STAGE(PG8_SA(0, 0), cA, voffA); PG8_STAGE(PG8_SB(0, 1), cB + hstep, voffB); PG8_STAGE(PG8_SA(0, 1), cA + hstep, voffA);
        if (wr == 1) PG8_BAR;
        PG8_WAIT_V(4); PG8_BAR;
        PG8_STAGE(PG8_SB(1, 0), cB + kstep, voffB); PG8_STAGE(PG8_SA(1, 0), cA + kstep, voffA); PG8_STAGE(PG8_SB(1, 1), cB + hstep + kstep, voffB);
        PG8_WAIT_V(6); PG8_BAR;
    }
    for (;;) {
        const bool has_next = S.next(ui + 1, nxt);
        const char* nA = has_next ? (const char*)g.A + (size_t)nxt.pm * tstep : cA; const char* nB = has_next ? (const char*)g.Bt + (size_t)nxt.pn * tstep : cB;
#pragma unroll 1
        for (int t = 0; t < nt; t += 2) {
            const bool last = (t == nt - 2);
            const char* a1 = cA + (size_t)(t + 1) * kstep;
            const char* a2 = last ? nA : cA + (size_t)(t + 2) * kstep; const char* b2 = last ? nB : cB + (size_t)(t + 2) * kstep;
            const char* a3 = a2 + kstep; const char* b3 = b2 + kstep;
            if (last && has_next) S.a_ready(nxt);
            if constexpr (SP2) {
            PG8_LDB(B0, 0, 0); PG8_LDB(B1, 0, 1); PG8_SCHED; PG8_LDA(At, 0, 0); PG8_STAGE(PG8_SA(1, 1), a1 + hstep, voffA);
            PG8_WAIT_V(8); PG8_WAIT_L(0); PG8_BAR; PG8_MMA(0, 0, At, B0); PG8_MMA(0, 1, At, B1); PG8_BAR; PG8_SCHED;
            PG8_LDA(At, 0, 1); PG8_STAGE(PG8_SB(0, 0), b2, voffB); PG8_STAGE(PG8_SB(0, 1), b2 + hstep, voffB); PG8_STAGE(PG8_SA(0, 0), a2, voffA);
            PG8_WAIT_V(8); PG8_WAIT_L(0); PG8_BAR; PG8_MMA(1, 0, At, B0); PG8_MMA(1, 1, At, B1); PG8_BAR; PG8_SCHED;
            PG8_LDB(B0, 1, 0); PG8_LDB(B1, 1, 1); PG8_SCHED; PG8_LDA(At, 1, 0); PG8_STAGE(PG8_SA(0, 1), a2 + hstep, voffA);
            PG8_WAIT_V(8); PG8_WAIT_L(0); PG8_BAR; PG8_MMA(0, 0, At, B0); PG8_MMA(0, 1, At, B1); PG8_BAR; PG8_SCHED;
            PG8_LDA(At, 1, 1); PG8_STAGE(PG8_SB(1, 0), b3, voffB); PG8_STAGE(PG8_SB(1, 1), b3 + hstep, voffB); PG8_STAGE(PG8_SA(1, 0), a3, voffA);
            PG8_WAIT_V(8); PG8_WAIT_L(0); PG8_BAR; PG8_MMA(1, 0, At, B0); PG8_MMA(1, 1, At, B1); PG8_BAR; PG8_SCHED;
            } else {
            PG8_LDB(B0, 0, 0); PG8_SCHED; PG8_LDA(At, 0, 0); PG8_STAGE(PG8_SA(1, 1), a1 + hstep, voffA);
            PG8_WAIT_L(8); PG8_BAR; PG8_WAIT_L(0); PG8_MMA(0, 0, At, B0); PG8_BAR; PG8_SCHED;
            PG8_LDB(B1, 0, 1); PG8_STAGE(PG8_SB(0, 0), b2, voffB);
            PG8_BAR; PG8_WAIT_L(0); PG8_MMA(0, 1, At, B1); PG8_BAR;
            PG8_LDA(At, 0, 1); PG8_STAGE(PG8_SA(0, 0), a2, voffA);
            PG8_BAR; PG8_WAIT_L(0); PG8_MMA(1, 0, At, B0); PG8_BAR; PG8_SCHED;
            PG8_STAGE(PG8_SB(0, 1), b2 + hstep, voffB);
            PG8_WAIT_V(6); PG8_BAR; PG8_MMA(1, 1, At, B1); PG8_BAR;
            PG8_LDB(B0, 1, 0); PG8_SCHED; PG8_LDA(At, 1, 0); PG8_STAGE(PG8_SA(0, 1), a2 + hstep, voffA);
            PG8_WAIT_L(8); PG8_BAR; PG8_WAIT_L(0); PG8_MMA(0, 0, At, B0); PG8_BAR; PG8_SCHED;
            PG8_LDB(B1, 1, 1); PG8_STAGE(PG8_SB(1, 0), b3, voffB);
            PG8_BAR; PG8_WAIT_L(0); PG8_MMA(0, 1, At, B1); PG8_BAR;
            PG8_LDA(At, 1, 1); PG8_STAGE(PG8_SA(1, 0), a3, voffA);
            PG8_BAR; PG8_WAIT_L(0); PG8_MMA(1, 0, At, B0); PG8_BAR; PG8_SCHED;
            PG8_STAGE(PG8_SB(1, 1), b3 + hstep, voffB);
            PG8_WAIT_V(6); PG8_BAR; PG8_MMA(1, 1, At, B1); PG8_BAR;
            }
        }
        if constexpr (ALIGN_EPI) { if (wr == 0) PG8_BAR; }
        if constexpr (!Epi::AFTER_DRAIN) { E(acc, cur, wr, wc, fr, fq); S.done(cur); }
        if (!has_next) break;
#pragma unroll
        for (int a = 0; a < 2; ++a)
#pragma unroll
            for (int b = 0; b < 2; ++b)
#pragma unroll
                for (int m = 0; m < 4; ++m)
#pragma unroll
                    for (int n = 0; n < 2; ++n) acc[a][b][m][n] = (f32x4){0.f, 0.f, 0.f, 0.f};
        cur = nxt; cA = nA; cB = nB; ++ui;
        if constexpr (ALIGN_EPI) { if (wr == 1) PG8_BAR; }
    }
    PG8_WAIT_V(0);
    if constexpr (!ALIGN_EPI) { if (wr == 0) PG8_BAR; }
    PG8_BAR;
    if constexpr (Epi::AFTER_DRAIN) { E.fused(acc, cur, wr, wc, fr, fq, lds, wid, lane); S.done(cur); }
#undef PG8_SA
#undef PG8_SB
#undef PG8_STAGE
#undef PG8_LDA
#undef PG8_LDB
#undef PG8_MMA
#undef PG8_WAIT_V
#undef PG8_WAIT_L
#undef PG8_BAR
#undef PG8_SCHED
}
}
#define GAS __attribute__((address_space(1)))
#define LAS __attribute__((address_space(3)))
typedef unsigned short bf16;
typedef unsigned v4u __attribute__((ext_vector_type(4)));
typedef float f32x4 __attribute__((ext_vector_type(4)));
typedef short bf16x8 __attribute__((ext_vector_type(8)));
typedef GAS unsigned gu32;
typedef GAS unsigned long long gu64;
#define RLX_AGENT __ATOMIC_RELAXED, __HIP_MEMORY_SCOPE_AGENT
#define LDS_WAIT() asm volatile("s_waitcnt lgkmcnt(0)" ::: "memory")
#define VM_WAIT() asm volatile("s_waitcnt vmcnt(0)" ::: "memory")
__device__ __forceinline__ unsigned long long rt() { return __builtin_amdgcn_s_memrealtime(); }
__device__ __forceinline__ unsigned f2bf(float f) { unsigned u = __builtin_bit_cast(unsigned, f); return (u + 0x7fffu + ((u >> 16) & 1u)) >> 16; }
__device__ __forceinline__ unsigned pk2(float lo, float hi) { return f2bf(lo) | (f2bf(hi) << 16); }
#define XB_TMO      128
#define XB_XCNT(j)  (256  + 64 * (j))
#define XB_XSUB(j)  (1280 + 64 * (j))
#define XB_XGEN(j)  (2304 + 64 * (j))
#define XB_TOP      3328
#define XB_TOPGEN   3392
#define XCD_BAR_WORDS 3456
#define XB_SPIN_CAP (1u << 18)

__device__ __forceinline__ unsigned xb_ld(unsigned* p)              { return __hip_atomic_load(p, __ATOMIC_RELAXED, __HIP_MEMORY_SCOPE_AGENT); }
__device__ __forceinline__ unsigned xb_add(unsigned* p, unsigned v) { return __hip_atomic_fetch_add(p, v, __ATOMIC_RELAXED, __HIP_MEMORY_SCOPE_AGENT); }
__device__ __forceinline__ unsigned xb_xcc_id() { return (unsigned)__builtin_amdgcn_s_getreg((3 << 11) | 20) & 0xFu; }
#define XB_SPIN(cond, bar) do { unsigned _sp = 0; while (cond) { __builtin_amdgcn_s_sleep(1); \
    if ((++_sp & 255u) == 0u) { if (xb_ld(&(bar)[XB_TMO])) break; if (_sp > XB_SPIN_CAP) { atomicAdd(&(bar)[XB_TMO], 1u); break; } } } } while (0)

struct XcdBarrier {
    unsigned* bar; unsigned x;
    volatile LAS unsigned* st;
};

__device__ __forceinline__ XcdBarrier xcd_barrier_post(unsigned* bar, volatile LAS unsigned* st) {
    XcdBarrier b; b.bar = bar; b.x = xb_xcc_id(); b.st = st;
    if (threadIdx.x == 0) (void)xb_add(&bar[XB_XCNT(b.x)], 1u);
    return b;
}
__device__ __forceinline__ void xcd_barrier_complete(unsigned* bar, unsigned x, unsigned& nloc, unsigned& nx) {
    const unsigned G = gridDim.x * gridDim.y * gridDim.z;
    unsigned sum, cnt, mine, sp = 0u;
    for (;;) {
        sum = 0u; cnt = 0u; mine = 0u;
#pragma unroll
        for (unsigned j = 0; j < 16; ++j) { const unsigned c = xb_ld(&bar[XB_XCNT(j)]); sum += c; cnt += (c > 0u) ? 1u : 0u; mine = (j == x) ? c : mine; }
        if (sum == G) break;
        __builtin_amdgcn_s_sleep(1);
        if ((++sp & 255u) == 0u) { if (xb_ld(&bar[XB_TMO])) break; if (sp > XB_SPIN_CAP) { atomicAdd(&bar[XB_TMO], 1u); break; } }
    }
    nloc = mine > 0u ? mine : 1u; nx = cnt > 0u ? cnt : 1u;
}

__device__ __forceinline__ void xcd_barrier(const XcdBarrier& b) {
    asm volatile("s_waitcnt vmcnt(0)" ::: "memory");
    __syncthreads();
    if (threadIdx.x == 0) {
        unsigned* bar = b.bar;
        __builtin_amdgcn_s_waitcnt(0);
        unsigned nloc = b.st[0], nx = b.st[1];
        if (nloc == 0u) { xcd_barrier_complete(bar, b.x, nloc, nx); b.st[0] = nloc; b.st[1] = nx; }
        const unsigned old = xb_add(&bar[XB_XSUB(b.x)], 1u);
        const unsigned gen = old / nloc;
        if (old + 1u == (gen + 1u) * nloc) {
            __builtin_amdgcn_fence(__ATOMIC_RELEASE, "agent");
            asm volatile("s_waitcnt vmcnt(0)" ::: "memory");
            const unsigned og = xb_add(&bar[XB_TOP], 1u);
            const unsigned tg = og / nx;
            if (og + 1u == (tg + 1u) * nx) xb_add(&bar[XB_TOPGEN], 1u);
            else XB_SPIN(xb_ld(&bar[XB_TOPGEN]) == tg, bar);
            __builtin_amdgcn_fence(__ATOMIC_ACQUIRE, "agent");
            xb_add(&bar[XB_XGEN(b.x)], 1u);
            asm volatile("s_waitcnt vmcnt(0)" ::: "memory");
        } else {
            XB_SPIN(xb_ld(&bar[XB_XGEN(b.x)]) == gen, bar);
            __builtin_amdgcn_fence(__ATOMIC_ACQUIRE, "agent");
            asm volatile("s_waitcnt vmcnt(0)" ::: "memory");
        }
    }
    __syncthreads();
}
constexpr int NWAVES = 8;
constexpr int BATCH = 8, SEQ = 2048, DM = 1024, T = BATCH * SEQ;
constexpr float LN_EPS = 1e-5f, DN_ALPHA = 1.4142135623730951f;
constexpr float MLA_QS = 0.07216878364870322f * 1.4426950408889634f;
constexpr size_t MiB = 1u << 20;
constexpr size_t WS_CTL = 0, CTL_ZERO_BYTES = 1 * MiB;
constexpr size_t WS_W_RIN = 1 * MiB, WS_W_ROUT = 13 * MiB, WS_W_MIN = 17 * MiB, WS_W_UQ = 19 * MiB, WS_W_UKV = 21 * MiB, WS_W_MOUT = 22 * MiB, WS_W_PQ = 24 * MiB, WS_W_SK = 32 * MiB;
constexpr size_t WS_PU = 33 * MiB, WS_PV = 97 * MiB, WS_HB = 161 * MiB, WS_SELI = 193 * MiB, WS_SELG = 201 * MiB;
constexpr size_t WS_ACT = 209 * MiB;
constexpr size_t WS_RQ = WS_ACT, WS_RK = WS_ACT + 32 * MiB, WS_RV = WS_ACT + 64 * MiB, WS_RG = WS_ACT + 128 * MiB;
constexpr size_t WS_QP = WS_ACT;
constexpr size_t WS_MC = WS_ACT, WS_CQN = WS_ACT + 48 * MiB, WS_CKVN = WS_ACT + 60 * MiB, WS_KROPE = WS_ACT + 68 * MiB, WS_MQ = WS_ACT + 70 * MiB, WS_MKV = WS_ACT + 118 * MiB, WS_MO = WS_ACT + 182 * MiB;
constexpr size_t WS_END = WS_ACT + 214 * MiB;
constexpr int CW_BAR = 4096;
constexpr int RING_BYTES = 131072, LDSCTL_OFF = RING_BYTES, MISC_OFF = LDSCTL_OFF + 320, LDS_BYTES = 147456;

__device__ __forceinline__ float bf2f(bf16 v) { return __builtin_bit_cast(float, (unsigned)v << 16); }
__device__ __forceinline__ float wave_sum(float v) {
#pragma unroll
    for (int o = 1; o < 64; o <<= 1) v += __shfl_xor(v, o);
    return v;
}
__device__ __forceinline__ float vmaxf(float a, float b) { return __builtin_fmaxf(a, b); }
__device__ __forceinline__ float vminf(float a, float b) { return __builtin_fminf(a, b); }
typedef float f32x16 __attribute__((ext_vector_type(16)));
typedef short s16x4 __attribute__((ext_vector_type(4)));
__device__ __forceinline__ int crow0(int r) { return (r & 3) + 8 * (r >> 2); }
__device__ __forceinline__ s16x4 vtr(const LAS unsigned char* p) { return __builtin_bit_cast(s16x4, __builtin_amdgcn_ds_read_tr16_b64_v4i16((LAS s16x4*)p)); }

struct Frame {
    LAS unsigned char* lds;
    int tid, lane, wave, vcu, G;
};

template <int NMAP>
__device__ __forceinline__ void p0_transpose_item(const float* W, int K, int N, bf16* WT, LAS float* scr, int item, int lane) {
    const int nblk = N / 32, kb = item / nblk, nb = item % nblk, k0 = 64 * kb, n0 = 32 * nb;
    int no = n0;
    if (NMAP == 1) { const int h = n0 / 192, d0 = n0 % 192; no = (d0 < 128) ? (h * 128 + d0) : (1024 + 256 * (h >> 2) + (h & 3) * 32 + (d0 == 160 ? 128 : 0)); }
#pragma unroll 8
    for (int i = 0; i < 32; ++i) { const int kk = 2 * i + (lane >> 5); scr[kk * 33 + (lane & 31)] = W[(size_t)(k0 + kk) * N + n0 + (lane & 31)]; }
    LDS_WAIT(); asm volatile("" ::: "memory");
    const int c = lane & 7;
#pragma unroll
    for (int j = 0; j < 4; ++j) { const int n = (lane >> 3) + 8 * j; const LAS float* s = scr + (8 * c) * 33 + n;
        v4u o; o.x = pk2(s[0 * 33], s[1 * 33]); o.y = pk2(s[2 * 33], s[3 * 33]); o.z = pk2(s[4 * 33], s[5 * 33]); o.w = pk2(s[6 * 33], s[7 * 33]);
        *(GAS v4u*)(WT + (size_t)(no + n) * K + k0 + 8 * c) = o; }
    LDS_WAIT(); asm volatile("" ::: "memory");
}
__device__ __forceinline__ void cvt_range(const float* src, bf16* dst, size_t n, int gw, int NGW, int lane) {
    const size_t nchunk = n / 2048;
    for (size_t c = gw; c < nchunk; c += NGW) {
        const float* s = src + c * 2048 + lane * 8; bf16* d = dst + c * 2048 + lane * 8;
        f32x4 a[4], b[4];
#pragma unroll
        for (int j = 0; j < 4; ++j) { a[j] = *(const GAS f32x4*)(s + j * 512); b[j] = *(const GAS f32x4*)(s + j * 512 + 4); }
#pragma unroll
        for (int j = 0; j < 4; ++j) { v4u o; o.x = pk2(a[j][0], a[j][1]); o.y = pk2(a[j][2], a[j][3]); o.z = pk2(b[j][0], b[j][1]); o.w = pk2(b[j][2], b[j][3]); *(GAS v4u*)(d + j * 512) = o; }
    }
}
struct Ptrs {
    const float *x; const int* pos;
    const float *ret_w_in, *ret_decay, *ret_gn_g, *ret_gn_b, *ret_w_out, *mla_w_in, *mla_qn, *mla_kvn, *mla_w_uq, *mla_w_ukv, *mla_w_out, *peer_w_q, *peer_sk, *peer_u, *peer_v, *ln_mix_g, *ln_mix_b, *ln_ffn_g, *ln_ffn_b;
    float* H; unsigned char* ws;
};
__device__ __forceinline__ void p0_prologue(const Frame& F, const Ptrs& P) {
    LAS float* scr = (LAS float*)(F.lds + F.wave * 16384);
    const int gw = F.vcu * NWAVES + F.wave, NGW = F.G * NWAVES;
    unsigned char* ws = P.ws;
    constexpr int I0 = 16 * 192, I1 = 32 * 32, I2 = 16 * 22, I3 = 6 * 48, I4 = 4 * 64, I5 = 16 * 32, I6 = 16 * 64;
    constexpr int NITEMS = I0 + I1 + I2 + I3 + I4 + I5 + 2 * I6;
    for (int it = gw; it < NITEMS; it += NGW) {
        int r = it;
        if (r < I0) { p0_transpose_item<0>(P.ret_w_in, 1024, 6144, (bf16*)(ws + WS_W_RIN), scr, r, F.lane); continue; } r -= I0;
        if (r < I1) { p0_transpose_item<0>(P.ret_w_out, 2048, 1024, (bf16*)(ws + WS_W_ROUT), scr, r, F.lane); continue; } r -= I1;
        if (r < I2) { p0_transpose_item<0>(P.mla_w_in, 1024, 704, (bf16*)(ws + WS_W_MIN), scr, r, F.lane); continue; } r -= I2;
        if (r < I3) { p0_transpose_item<1>(P.mla_w_uq, 384, 1536, (bf16*)(ws + WS_W_UQ), scr, r, F.lane); continue; } r -= I3;
        if (r < I4) { p0_transpose_item<0>(P.mla_w_ukv, 256, 2048, (bf16*)(ws + WS_W_UKV), scr, r, F.lane); continue; } r -= I4;
        if (r < I5) { p0_transpose_item<0>(P.mla_w_out, 1024, 1024, (bf16*)(ws + WS_W_MOUT), scr, r, F.lane); continue; } r -= I5;
        if (r < I6) { p0_transpose_item<0>(P.peer_w_q, 1024, 2048, (bf16*)(ws + WS_W_PQ), scr, r, F.lane); continue; } r -= I6;
        p0_transpose_item<0>(P.peer_w_q + (size_t)1024 * 2048, 1024, 2048, (bf16*)(ws + WS_W_PQ) + (size_t)1024 * 2048, scr, r, F.lane);
    }
    for (int c = gw; c < 32; c += NGW) { GAS v4u* d = (GAS v4u*)((bf16*)(ws + WS_W_MIN) + (size_t)704 * 1024 + c * 2048) + F.lane * 4;
#pragma unroll
        for (int j = 0; j < 4; ++j) d[j] = (v4u){0u, 0u, 0u, 0u}; }
    cvt_range(P.peer_sk, (bf16*)(ws + WS_W_SK), (size_t)2 * 8 * 2 * 128 * 128, gw, NGW, F.lane);
    cvt_range(P.x, (bf16*)(ws + WS_HB), (size_t)T * DM, gw, NGW, F.lane);
    cvt_range(P.peer_u, (bf16*)(ws + WS_PU), (size_t)2 * 16384 * 1024, gw, NGW, F.lane);
    cvt_range(P.peer_v, (bf16*)(ws + WS_PV), (size_t)2 * 16384 * 1024, gw, NGW, F.lane);
}

__device__ __forceinline__ void ln_rows(const Frame& F, float* H, bf16* HB, const float* g, const float* b) {
    const int gw = F.vcu * NWAVES + F.wave, NGW = F.G * NWAVES;
    f32x4 gv[4], bv[4];
#pragma unroll
    for (int j = 0; j < 4; ++j) { gv[j] = *(const GAS f32x4*)(g + 4 * F.lane + 256 * j); bv[j] = *(const GAS f32x4*)(b + 4 * F.lane + 256 * j); }
    for (int m = gw; m < T; m += NGW) {
        GAS f32x4* xr = (GAS f32x4*)(H + (size_t)m * DM) + F.lane;
        f32x4 v[4]; float s = 0.f;
#pragma unroll
        for (int j = 0; j < 4; ++j) { v[j] = xr[64 * j]; s += (v[j].x + v[j].y) + (v[j].z + v[j].w); }
        const float mean = wave_sum(s) * (1.f / DM); float s2 = 0.f;
#pragma unroll
        for (int j = 0; j < 4; ++j) { v[j] = v[j] - mean; s2 += (v[j].x * v[j].x + v[j].y * v[j].y) + (v[j].z * v[j].z + v[j].w * v[j].w); }
        const float rstd = 1.f / sqrtf(wave_sum(s2) * (1.f / DM) + LN_EPS);
        GAS unsigned long long* o8 = (GAS unsigned long long*)(HB + (size_t)m * DM) + F.lane;
#pragma unroll
        for (int j = 0; j < 4; ++j) { const f32x4 y = v[j] * rstd * gv[j] + bv[j]; xr[64 * j] = y;
            o8[64 * j] = (unsigned long long)pk2(y.x, y.y) | ((unsigned long long)pk2(y.z, y.w) << 32); }
    }
}
__device__ __forceinline__ void mla_rows(const Frame& F, const Ptrs& P) {
    const int gw = F.vcu * NWAVES + F.wave, NGW = F.G * NWAVES, lane = F.lane;
    const float* C = (const float*)(P.ws + WS_MC); bf16* cqn = (bf16*)(P.ws + WS_CQN); bf16* ckvn = (bf16*)(P.ws + WS_CKVN); bf16* kr = (bf16*)(P.ws + WS_KROPE);
    float gq[6], gk[4];
#pragma unroll
    for (int j = 0; j < 6; ++j) gq[j] = P.mla_qn[lane + 64 * j];
#pragma unroll
    for (int j = 0; j < 4; ++j) gk[j] = P.mla_kvn[lane + 64 * j];
    const float fv = __builtin_amdgcn_exp2f(-(float)(lane & 31) * (13.287712379549449f / 32.0f)) * 0.15915494309189535f;
    for (int t = gw; t < T; t += NGW) {
        const float* c = C + (size_t)t * 768;
        float a[6], k[4]; float s = 0.f, s2 = 0.f;
#pragma unroll
        for (int j = 0; j < 6; ++j) { a[j] = c[lane + 64 * j]; s += a[j] * a[j]; }
#pragma unroll
        for (int j = 0; j < 4; ++j) { k[j] = c[384 + lane + 64 * j]; s2 += k[j] * k[j]; }
        const float v = c[640 + lane];
        const float rq = 1.f / sqrtf(wave_sum(s) * (1.f / 384.f) + LN_EPS), rk = 1.f / sqrtf(wave_sum(s2) * (1.f / 256.f) + LN_EPS);
#pragma unroll
        for (int j = 0; j < 6; ++j) cqn[(size_t)t * 384 + lane + 64 * j] = (bf16)f2bf(a[j] * rq * gq[j]);
#pragma unroll
        for (int j = 0; j < 4; ++j) ckvn[(size_t)t * 256 + lane + 64 * j] = (bf16)f2bf(k[j] * rk * gk[j]);
        const float pv = __shfl_xor(v, 32);
        float ang = (float)P.pos[t] * fv; ang = __builtin_amdgcn_fractf(ang);
        const float sn = __builtin_amdgcn_sinf(ang), cs = __builtin_amdgcn_cosf(ang);
        const float o = (lane < 32) ? (v * cs - pv * sn) : (pv * sn + v * cs);
        kr[(size_t)t * 64 + lane] = (bf16)f2bf(o);
    }
}

__device__ __forceinline__ void ret_unit(LAS unsigned char* lds, const bf16* __restrict__ Qg, const bf16* __restrict__ Kg, const bf16* __restrict__ Vg, bf16* Gz,
                                         const float* gng, const float* gnb, float lf, float lb, int b, int h, int qb) {
    int tid = threadIdx.x; asm volatile("" : "+v"(tid));
    const int lane = tid & 63, wid = __builtin_amdgcn_readfirstlane(tid >> 6);
    const int qg = wid >> 1, vg = wid & 1, r32 = lane & 31, hh = lane >> 5;
    constexpr int QL = 0, KL = 65536, VL = 81920, SCR = 114688;
    const size_t rowbase = (size_t)b * SEQ;
#pragma unroll
    for (int i = 0; i < 8; ++i) { const int c = tid + 512 * i, row = c >> 5, ch = c & 31;
        const v4u v = *(const GAS v4u*)(Qg + (rowbase + qb * 128 + row) * 1024 + h * 256 + ch * 8);
        *(LAS v4u*)(lds + QL + row * 512 + ((ch ^ (row & 7)) << 4)) = v; }
    const int kr0 = 2 * wid + (lane >> 5);
    const bf16* ksrc = Kg + (rowbase + kr0) * 1024 + h * 256 + (((lane & 31) ^ (kr0 & 7)) * 8);
    const bf16* vsrc = Vg + (rowbase + ((lane & 31) >> 2)) * 2048 + h * 512 + 32 * kr0 + 8 * (lane & 3);
#define RET_DMA_K(kt) do { _Pragma("unroll") for (int i = 0; i < 2; ++i) \
    __builtin_amdgcn_global_load_lds((const unsigned*)(ksrc + ((size_t)(kt) * 32 + 16 * i) * 1024), (LAS unsigned*)(lds + KL + (wid + 8 * i) * 1024), 16, 0, 0); } while (0)
#define RET_DMA_V(kt) do { _Pragma("unroll") for (int i = 0; i < 4; ++i) \
    __builtin_amdgcn_global_load_lds((const unsigned*)(vsrc + ((size_t)(kt) * 32 + 8 * i) * 2048), (LAS unsigned*)(lds + VL + (wid + 8 * i) * 1024), 16, 0, 0); } while (0)
    RET_DMA_K(0); RET_DMA_V(0);
    VM_WAIT(); __syncthreads();
    f32x16 o[8];
#pragma unroll
    for (int d = 0; d < 8; ++d) o[d] = (f32x16){};
    const int nq = qb * 128 + qg * 32 + r32, sw = r32 & 7;
    const LAS unsigned char* kp = lds + KL + r32 * 512;
    const LAS unsigned char* qp = lds + QL + (qg * 32 + r32) * 512;
    const LAS unsigned char* vp = lds + VL + vg * 8 * 512 + (4 * hh + ((lane & 15) >> 2)) * 64 + (((lane >> 4) & 1) * 16 + 4 * (lane & 3)) * 2;
    for (int kt = 0; kt < SEQ / 32; ++kt) {
        f32x16 s = (f32x16){};
#pragma unroll
        for (int si = 0; si < 16; ++si) { const int off = ((2 * si + hh) ^ sw) << 4;
            const bf16x8 a = *(const LAS bf16x8*)(kp + off), bq = *(const LAS bf16x8*)(qp + off);
            s = __builtin_amdgcn_mfma_f32_32x32x16_bf16(a, bq, s, 0, 0, 0);
            if ((si & 3) == 3) __builtin_amdgcn_sched_barrier(0); }
        const float dbase = (float)(nq - kt * 32 - 4 * hh);
        unsigned pw[8];
#pragma unroll
        for (int r = 0; r < 16; r += 2) {
            const float d0 = dbase - (float)crow0(r), d1 = dbase - (float)crow0(r + 1);
            const float w0 = __builtin_amdgcn_exp2f(fminf(lf * d0, -lb * d0)), w1 = __builtin_amdgcn_exp2f(fminf(lf * d1, -lb * d1));
            pw[r >> 1] = pg8::cvt_pk_bf16(s[r] * w0, s[r + 1] * w1);
        }
        const bf16x8 pa0 = __builtin_bit_cast(bf16x8, (v4u){pw[0], pw[1], pw[2], pw[3]}), pa1 = __builtin_bit_cast(bf16x8, (v4u){pw[4], pw[5], pw[6], pw[7]});
        VM_WAIT(); __syncthreads();
        if (kt + 1 < SEQ / 32) RET_DMA_K(kt + 1);
#pragma unroll
        for (int dt = 0; dt < 8; ++dt) {
#pragma unroll
            for (int sh = 0; sh < 2; ++sh) {
                const s16x4 lo = vtr(vp + ((2 * sh) * 16 + dt) * 512), hi = vtr(vp + ((2 * sh + 1) * 16 + dt) * 512);
                const bf16x8 vb = (bf16x8){lo[0], lo[1], lo[2], lo[3], hi[0], hi[1], hi[2], hi[3]};
                o[dt] = __builtin_amdgcn_mfma_f32_32x32x16_bf16(sh ? pa1 : pa0, vb, o[dt], 0, 0, 0);
            }
            if (dt & 1) __builtin_amdgcn_sched_barrier(0);
        }
        VM_WAIT(); __syncthreads();
        if (kt + 1 < SEQ / 32) RET_DMA_V(kt + 1);
    }
#undef RET_DMA_K
#undef RET_DMA_V
    float sm[16], sq[16];
#pragma unroll
    for (int r = 0; r < 16; ++r) { float a = 0.f, q = 0.f;
#pragma unroll
        for (int dt = 0; dt < 8; ++dt) { const float v = o[dt][r]; a += v; q += v * v; }
#pragma unroll
        for (int of = 1; of < 32; of <<= 1) { a += __shfl_xor(a, of); q += __shfl_xor(q, of); }
        sm[r] = a; sq[r] = q; if ((r & 1) == 1) __builtin_amdgcn_sched_barrier(0); }
    LAS float* scr = (LAS float*)(lds + SCR);
    if (r32 == 0) {
#pragma unroll
        for (int r = 0; r < 16; ++r) { const int row = crow0(r) + 4 * hh; scr[((qg * 2 + vg) * 32 + row) * 2] = sm[r]; scr[((qg * 2 + vg) * 32 + row) * 2 + 1] = sq[r]; } }
    __syncthreads();
    float gg[8], gb[8];
#pragma unroll
    for (int dt = 0; dt < 8; ++dt) { const int col = h * 512 + vg * 256 + dt * 32 + r32; gg[dt] = gng[col]; gb[dt] = gnb[col]; }
#pragma unroll
    for (int r = 0; r < 16; ++r) {
        const int row = crow0(r) + 4 * hh;
        const float a = scr[((qg * 2) * 32 + row) * 2] + scr[((qg * 2 + 1) * 32 + row) * 2], q = scr[((qg * 2) * 32 + row) * 2 + 1] + scr[((qg * 2 + 1) * 32 + row) * 2 + 1];
        const float mean = a * (1.f / 512.f), var = q * (1.f / 512.f) - mean * mean, rstd = 1.f / sqrtf(var + LN_EPS);
        bf16* gp = Gz + (rowbase + qb * 128 + qg * 32 + row) * 2048 + h * 512 + vg * 256 + r32;
#pragma unroll
        for (int dt = 0; dt < 8; ++dt) {
            const float yn = (o[dt][r] - mean) * rstd * gg[dt] + gb[dt];
            const float g = bf2f(gp[dt * 32]);
            const float z = g / (1.f + __expf(-g)) * yn;
            gp[dt * 32] = (bf16)f2bf(z);
        }
    }
    __syncthreads();
}

__device__ __forceinline__ void mla_unit(LAS unsigned char* lds, const bf16* __restrict__ Qg, const bf16* __restrict__ KVg, const bf16* __restrict__ KRg, bf16* Og, int b, int h, int qb) {
    int tid = threadIdx.x; asm volatile("" : "+v"(tid));
    const int lane = tid & 63, wid = __builtin_amdgcn_readfirstlane(tid >> 6);
    const int r32 = lane & 31, hh = lane >> 5;
    constexpr int STG = 40960, KOFF = 0, VOFF = 24576, SCR = 81920;
    const size_t rowbase = (size_t)b * SEQ;
    bf16x8 qf[12];
    { const bf16* qr = Qg + (rowbase + qb * 256 + wid * 32 + r32) * 1536;
#pragma unroll
      for (int s = 0; s < 8; ++s) qf[s] = *(const GAS bf16x8*)(qr + h * 128 + 16 * s + 8 * hh);
#pragma unroll
      for (int s = 0; s < 2; ++s) { qf[8 + s] = *(const GAS bf16x8*)(qr + 1024 + 256 * (h >> 2) + (h & 3) * 32 + 16 * s + 8 * hh);
                                    qf[10 + s] = *(const GAS bf16x8*)(qr + 1024 + 256 * (h >> 2) + 128 + (h & 3) * 32 + 16 * s + 8 * hh); } }
    const bf16* ksrc[3]; int kstr[3];
#pragma unroll
    for (int i = 0; i < 3; ++i) { const int off = 1024 * (wid + 8 * i) + 16 * lane, row = off / 384, pos = (off % 384) >> 4, ch = pos ^ (row & 7);
        if (ch < 16) { ksrc[i] = KVg + (rowbase + row) * 2048 + h * 256 + ch * 8; kstr[i] = 64 * 2048; }
        else         { ksrc[i] = KRg + (rowbase + row) * 64 + (ch - 16) * 8;       kstr[i] = 64 * 64; } }
    const int vs0 = 2 * wid + (lane >> 5);
    const bf16* vsrc = KVg + (rowbase + 8 * (vs0 >> 2) + ((lane & 31) >> 2)) * 2048 + h * 256 + 128 + 32 * (vs0 & 3) + 8 * (lane & 3);
#define MLA_DMA(kt, buf) do { \
    _Pragma("unroll") for (int i = 0; i < 3; ++i) __builtin_amdgcn_global_load_lds((const unsigned*)(ksrc[i] + (size_t)(kt) * kstr[i]), (LAS unsigned*)(lds + (buf) * STG + KOFF + (wid + 8 * i) * 1024), 16, 0, 0); \
    _Pragma("unroll") for (int i = 0; i < 2; ++i) __builtin_amdgcn_global_load_lds((const unsigned*)(vsrc + ((size_t)(kt) * 64 + 32 * i) * 2048), (LAS unsigned*)(lds + (buf) * STG + VOFF + (wid + 8 * i) * 1024), 16, 0, 0); } while (0)
    MLA_DMA(0, 0);
    f32x16 o[4];
#pragma unroll
    for (int d = 0; d < 4; ++d) o[d] = (f32x16){};
    float mref = -INFINITY, lsum = 0.f;
    const int sw = r32 & 7;
    LAS float* scr = (LAS float*)(lds + SCR) + wid * 64;
    const int vlane = VOFF + (4 * hh + ((lane & 15) >> 2)) * 64 + (((lane >> 4) & 1) * 16 + 4 * (lane & 3)) * 2;
    for (int kt = 0; kt < SEQ / 64; ++kt) {
        VM_WAIT(); __syncthreads();
        if (kt + 1 < SEQ / 64) { if (kt & 1) MLA_DMA(kt + 1, 0); else MLA_DMA(kt + 1, 1); }
        const LAS unsigned char* kb = lds + (kt & 1) * STG + KOFF + r32 * 384;
        const LAS unsigned char* vb = lds + (kt & 1) * STG + vlane;
        f32x16 s0 = (f32x16){}, s1 = (f32x16){};
#pragma unroll
        for (int si = 0; si < 12; ++si) { const int off = ((2 * si + hh) ^ sw) << 4;
            const bf16x8 a0 = *(const LAS bf16x8*)(kb + off), a1 = *(const LAS bf16x8*)(kb + 32 * 384 + off);
            s0 = __builtin_amdgcn_mfma_f32_32x32x16_bf16(a0, qf[si], s0, 0, 0, 0);
            s1 = __builtin_amdgcn_mfma_f32_32x32x16_bf16(a1, qf[si], s1, 0, 0, 0); }
        float mx = fmaxf(s0[0], s1[0]);
#pragma unroll
        for (int r = 1; r < 16; ++r) mx = fmaxf(mx, fmaxf(s0[r], s1[r]));
        mx = fmaxf(mx, __shfl_xor(mx, 32));
        if (__any(mx > mref + 8.0f)) {
            const float mnew = fmaxf(mref, mx); const float f = __builtin_amdgcn_exp2f(mref - mnew);
            lsum *= f; mref = mnew;
            if (hh == 0) scr[r32] = f;
            LDS_WAIT(); asm volatile("" ::: "memory");
#pragma unroll
            for (int r = 0; r < 16; ++r) { const float fr_ = scr[crow0(r) + 4 * hh];
#pragma unroll
                for (int d = 0; d < 4; ++d) o[d][r] *= fr_; }
        }
        unsigned pw0[8], pw1[8]; float ps = 0.f;
#pragma unroll
        for (int r = 0; r < 16; r += 2) {
            const float a0 = __builtin_amdgcn_exp2f(s0[r] - mref), a1 = __builtin_amdgcn_exp2f(s0[r + 1] - mref);
            const float b0 = __builtin_amdgcn_exp2f(s1[r] - mref), b1 = __builtin_amdgcn_exp2f(s1[r + 1] - mref);
            ps += (a0 + a1) + (b0 + b1);
            pw0[r >> 1] = pg8::cvt_pk_bf16(a0, a1); pw1[r >> 1] = pg8::cvt_pk_bf16(b0, b1);
        }
        lsum += ps;
        bf16x8 pa[2][2];
        pa[0][0] = __builtin_bit_cast(bf16x8, (v4u){pw0[0], pw0[1], pw0[2], pw0[3]}); pa[0][1] = __builtin_bit_cast(bf16x8, (v4u){pw0[4], pw0[5], pw0[6], pw0[7]});
        pa[1][0] = __builtin_bit_cast(bf16x8, (v4u){pw1[0], pw1[1], pw1[2], pw1[3]}); pa[1][1] = __builtin_bit_cast(bf16x8, (v4u){pw1[4], pw1[5], pw1[6], pw1[7]});
#pragma unroll
        for (int dt = 0; dt < 4; ++dt)
#pragma unroll
            for (int st = 0; st < 2; ++st)
#pragma unroll
                for (int sh = 0; sh < 2; ++sh) {
                    const s16x4 lo = vtr(vb + ((4 * st + 2 * sh) * 4 + dt) * 512), hi = vtr(vb + ((4 * st + 2 * sh + 1) * 4 + dt) * 512);
                    const bf16x8 vv = (bf16x8){lo[0], lo[1], lo[2], lo[3], hi[0], hi[1], hi[2], hi[3]};
                    o[dt] = __builtin_amdgcn_mfma_f32_32x32x16_bf16(pa[st][sh], vv, o[dt], 0, 0, 0);
                }
    }
#undef MLA_DMA
    lsum += __shfl_xor(lsum, 32);
    if (hh == 0) scr[32 + r32] = lsum;
    LDS_WAIT(); asm volatile("" ::: "memory");
#pragma unroll
    for (int r = 0; r < 16; ++r) {
        const int row = crow0(r) + 4 * hh; const float il = 1.f / scr[32 + row];
        bf16* op = Og + (rowbase + qb * 256 + wid * 32 + row) * 1024 + h * 128 + r32;
#pragma unroll
        for (int dt = 0; dt < 4; ++dt) op[dt * 32] = (bf16)f2bf(o[dt][r] * il);
    }
    __syncthreads();
}

#define INS16(L, xin) do { float xx_ = (xin); _Pragma("unroll") for (int i_ = 0; i_ < 16; ++i_) { const float t_ = vmaxf(L[i_], xx_); xx_ = vminf(L[i_], xx_); L[i_] = t_; } } while (0)
__device__ __forceinline__ void topk_unit(LAS unsigned char* lds, const bf16* __restrict__ Qp, const bf16* __restrict__ SK, int* seli, float* selg, int tt, int h) {
    int tid = threadIdx.x; asm volatile("" : "+v"(tid));
    const int lane = tid & 63, wid = __builtin_amdgcn_readfirstlane(tid >> 6);
    const int r32 = lane & 31, hh = lane >> 5, sw = r32 & 7;
    const int token = tt * 256 + wid * 32 + r32;
    float AB[2][16];
#pragma unroll
    for (int c = 0; c < 2; ++c) {
        __syncthreads();
#pragma unroll
        for (int i = 0; i < 4; ++i) { const int cc = tid + 512 * i, row = cc >> 4, ch = cc & 15;
            const v4u v = *(const GAS v4u*)(SK + ((size_t)(h * 2 + c) * 128 + row) * 128 + ch * 8);
            *(LAS v4u*)(lds + row * 256 + ((ch ^ (row & 7)) << 4)) = v; }
        bf16x8 qf[8];
#pragma unroll
        for (int s = 0; s < 8; ++s) qf[s] = *(const GAS bf16x8*)(Qp + (size_t)token * 2048 + h * 256 + c * 128 + 16 * s + 8 * hh);
        __syncthreads();
        float L[16];
#pragma unroll
        for (int i = 0; i < 16; ++i) L[i] = -INFINITY;
#pragma unroll
        for (int kt = 0; kt < 4; ++kt) {
            f32x16 acc = (f32x16){};
#pragma unroll
            for (int s = 0; s < 8; ++s) { const bf16x8 a = *(const LAS bf16x8*)(lds + (kt * 32 + r32) * 256 + (((2 * s + hh) ^ sw) << 4));
                acc = __builtin_amdgcn_mfma_f32_32x32x16_bf16(a, qf[s], acc, 0, 0, 0); }
#pragma unroll
            for (int r = 0; r < 16; ++r) { const unsigned key = (unsigned)(kt * 32 + crow0(r)) + 4u * (unsigned)hh;
                const float av = acc[r];
                const float x = __builtin_bit_cast(float, (__builtin_bit_cast(unsigned, av) & ~127u) | key); INS16(L, x); }
        }
        float M[16];
#pragma unroll
        for (int i = 0; i < 16; ++i) M[i] = vmaxf(L[i], __shfl_xor(L[15 - i], 32));
#pragma unroll
        for (int d = 8; d >= 1; d >>= 1)
#pragma unroll
            for (int i = 0; i < 16; ++i) if ((i & d) == 0) { const float a = vmaxf(M[i], M[i + d]), bq = vminf(M[i], M[i + d]); M[i] = a; M[i + d] = bq; }
#pragma unroll
        for (int i = 0; i < 16; ++i) AB[c][i] = M[i];
    }
    float W[16];
#pragma unroll
    for (int i = 0; i < 16; ++i) W[i] = -INFINITY;
#pragma unroll
    for (int i = 0; i < 16; ++i)
#pragma unroll
        for (int j = 0; j < 16; ++j) if ((i + 1) * (j + 1) <= 16) {
            const float sum = AB[0][i] + AB[1][j];
            const float x = __builtin_bit_cast(float, (__builtin_bit_cast(unsigned, sum) & ~255u) | (unsigned)(i * 16 + j)); INS16(W, x); }
    LAS unsigned char* tb = lds + 32768 + wid * 1024 + r32 * 32;
    if (hh == 0) {
#pragma unroll
        for (int c = 0; c < 2; ++c)
#pragma unroll
            for (int q = 0; q < 4; ++q) { unsigned w = 0;
#pragma unroll
                for (int e = 0; e < 4; ++e) w |= (__builtin_bit_cast(unsigned, AB[c][4 * q + e]) & 127u) << (8 * e);
                *(LAS unsigned*)(tb + c * 16 + 4 * q) = w; }
    }
    LDS_WAIT(); asm volatile("" ::: "memory");
    float Z = 0.f;
#pragma unroll
    for (int k = 0; k < 16; ++k) Z += __expf(W[k] - W[0]);
    const float iz = 1.f / Z;
    int ei[8]; float eg[8];
#pragma unroll
    for (int k = 0; k < 8; ++k) {
        float wa_ = W[k], wb_ = W[8 + k]; asm volatile("" : "+v"(wa_), "+v"(wb_));
        const float w = hh ? wb_ : wa_;
        const unsigned ij = __builtin_bit_cast(unsigned, w) & 255u;
        const unsigned k1 = tb[ij >> 4], k2 = tb[16 + (ij & 15)];
        ei[k] = (int)(k1 * 128u + k2); eg[k] = __expf(w - W[0]) * iz;
    }
    int* ip = seli + (size_t)token * 128 + h * 16 + 8 * hh; float* gp = selg + (size_t)token * 128 + h * 16 + 8 * hh;
    *(GAS v4u*)ip = (v4u){(unsigned)ei[0], (unsigned)ei[1], (unsigned)ei[2], (unsigned)ei[3]}; *(GAS v4u*)(ip + 4) = (v4u){(unsigned)ei[4], (unsigned)ei[5], (unsigned)ei[6], (unsigned)ei[7]};
    *(GAS f32x4*)gp = (f32x4){eg[0], eg[1], eg[2], eg[3]}; *(GAS f32x4*)(gp + 4) = (f32x4){eg[4], eg[5], eg[6], eg[7]};
}

__device__ __forceinline__ void topk_brute_unit(LAS unsigned char* lds, const bf16* __restrict__ Qp, const bf16* __restrict__ SK, int* seli, float* selg, int tt, int h) {
    const int tid = threadIdx.x;
    const int token = tt * 512 + tid;
    float AB[2][16];
#pragma unroll
    for (int c = 0; c < 2; ++c) {
        __syncthreads();
#pragma unroll
        for (int i = 0; i < 4; ++i) { const int cc = tid + 512 * i, row = cc >> 4, ch = cc & 15;
            const v4u v = *(const GAS v4u*)(SK + ((size_t)(h * 2 + c) * 128 + row) * 128 + ch * 8);
            *(LAS v4u*)(lds + row * 256 + (ch << 4)) = v; }
        __syncthreads();
        unsigned q[64];
#pragma unroll
        for (int i = 0; i < 16; ++i) { const v4u v = *(const GAS v4u*)(Qp + (size_t)token * 2048 + h * 256 + c * 128 + i * 8); q[4 * i] = v.x; q[4 * i + 1] = v.y; q[4 * i + 2] = v.z; q[4 * i + 3] = v.w; }
        float L[16];
#pragma unroll
        for (int i = 0; i < 16; ++i) L[i] = -INFINITY;
#pragma unroll 1
        for (int key = 0; key < 128; ++key) {
            float s = 0.f;
#pragma unroll
            for (int i = 0; i < 64; ++i) { const unsigned kw = *(const LAS unsigned*)(lds + key * 256 + i * 4);
                s += __builtin_bit_cast(float, kw << 16) * __builtin_bit_cast(float, q[i] << 16) + __builtin_bit_cast(float, kw & 0xffff0000u) * __builtin_bit_cast(float, q[i] & 0xffff0000u); }
            const float x = __builtin_bit_cast(float, (__builtin_bit_cast(unsigned, s) & ~127u) | (unsigned)key); INS16(L, x);
        }
#pragma unroll
        for (int i = 0; i < 16; ++i) AB[c][i] = L[i];
    }
    float W[16];
#pragma unroll
    for (int i = 0; i < 16; ++i) W[i] = -INFINITY;
#pragma unroll
    for (int i = 0; i < 16; ++i)
#pragma unroll
        for (int j = 0; j < 16; ++j) if ((i + 1) * (j + 1) <= 16) {
            const float sum = AB[0][i] + AB[1][j];
            const float x = __builtin_bit_cast(float, (__builtin_bit_cast(unsigned, sum) & ~255u) | (unsigned)(i * 16 + j)); INS16(W, x); }
    __syncthreads();
    LAS unsigned char* tb = lds + tid * 32;
#pragma unroll
    for (int c = 0; c < 2; ++c)
#pragma unroll
        for (int qd = 0; qd < 4; ++qd) { unsigned w = 0;
#pragma unroll
            for (int e = 0; e < 4; ++e) w |= (__builtin_bit_cast(unsigned, AB[c][4 * qd + e]) & 127u) << (8 * e);
            *(LAS unsigned*)(tb + c * 16 + 4 * qd) = w; }
    LDS_WAIT(); asm volatile("" ::: "memory");
    float Z = 0.f;
#pragma unroll
    for (int k = 0; k < 16; ++k) Z += __expf(W[k] - W[0]);
    const float iz = 1.f / Z;
#pragma unroll
    for (int k = 0; k < 16; ++k) {
        const unsigned ij = __builtin_bit_cast(unsigned, W[k]) & 255u;
        const unsigned k1 = tb[ij >> 4], k2 = tb[16 + (ij & 15)];
        seli[(size_t)token * 128 + h * 16 + k] = (int)(k1 * 128u + k2); selg[(size_t)token * 128 + h * 16 + k] = __expf(W[k] - W[0]) * iz;
    }
}

typedef __bf16 bf16v2 __attribute__((ext_vector_type(2)));
__device__ __forceinline__ float dot2bf(unsigned a, unsigned x, float acc) { return __builtin_amdgcn_fdot2_f32_bf16(__builtin_bit_cast(bf16v2, a), __builtin_bit_cast(bf16v2, x), acc, false); }
__device__ __forceinline__ float dot8(const v4u a, const v4u x, float acc) {
    const unsigned a0 = a.x, a1 = a.y, a2 = a.z, a3 = a.w, x0 = x.x, x1 = x.y, x2 = x.z, x3 = x.w;
    acc = dot2bf(a0, x0, acc); acc = dot2bf(a1, x1, acc); acc = dot2bf(a2, x2, acc); acc = dot2bf(a3, x3, acc);
    return acc;
}
#define AXPY8(ac, o, v, c) do { \
    ac[o + 0] += (c) * __builtin_bit_cast(float, (v).x << 16); ac[o + 1] += (c) * __builtin_bit_cast(float, (v).x & 0xffff0000u); \
    ac[o + 2] += (c) * __builtin_bit_cast(float, (v).y << 16); ac[o + 3] += (c) * __builtin_bit_cast(float, (v).y & 0xffff0000u); \
    ac[o + 4] += (c) * __builtin_bit_cast(float, (v).z << 16); ac[o + 5] += (c) * __builtin_bit_cast(float, (v).z & 0xffff0000u); \
    ac[o + 6] += (c) * __builtin_bit_cast(float, (v).w << 16); ac[o + 7] += (c) * __builtin_bit_cast(float, (v).w & 0xffff0000u); } while (0)
__device__ __forceinline__ void peer_gather(const Frame& F, float* H, bf16* HB, const int* seli, const float* selg, const bf16* __restrict__ PU, const bf16* __restrict__ PV, const float* lng, const float* lnb) {
    const int gw = F.vcu * NWAVES + F.wave, NGW = F.G * NWAVES, lane = F.lane;
    f32x4 gv[4], bv[4];
#pragma unroll
    for (int j = 0; j < 2; ++j) { gv[2 * j] = *(const GAS f32x4*)(lng + 512 * j + 8 * lane); gv[2 * j + 1] = *(const GAS f32x4*)(lng + 512 * j + 8 * lane + 4);
                                  bv[2 * j] = *(const GAS f32x4*)(lnb + 512 * j + 8 * lane); bv[2 * j + 1] = *(const GAS f32x4*)(lnb + 512 * j + 8 * lane + 4); }
    for (int t = gw; t < T; t += NGW) {
        const int i0 = seli[(size_t)t * 128 + lane], i1 = seli[(size_t)t * 128 + 64 + lane];
        const float g0 = selg[(size_t)t * 128 + lane], g1 = selg[(size_t)t * 128 + 64 + lane];
        const v4u xa = *(const GAS v4u*)(HB + (size_t)t * DM + 8 * lane), xb = *(const GAS v4u*)(HB + (size_t)t * DM + 512 + 8 * lane);
        float d0 = 0.f, d1 = 0.f;
#pragma unroll 1
        for (int e0 = 0; e0 < 128; e0 += 8) {
            v4u ua[8], ub[8];
            const int isel = (e0 < 64) ? i0 : i1;
#pragma unroll
            for (int k = 0; k < 8; ++k) { const int idx = __builtin_amdgcn_readlane(isel, (e0 + k) & 63);
                const bf16* row = PU + (size_t)idx * DM; ua[k] = *(const GAS v4u*)(row + 8 * lane); ub[k] = *(const GAS v4u*)(row + 512 + 8 * lane); }
            float dd = 0.f;
#pragma unroll
            for (int k = 0; k < 8; ++k) { float p = dot8(ua[k], xa, 0.f); p = dot8(ub[k], xb, p); p = wave_sum(p); if (lane == ((e0 + k) & 63)) dd = p; }
            if (e0 < 64) { if ((lane >> 3) == (e0 >> 3)) d0 = dd; } else { if ((lane >> 3) == ((e0 - 64) >> 3)) d1 = dd; }
        }
#ifndef ABL_PEER
#define ABL_PEER 1.0f
#endif
        const float c0 = ABL_PEER * g0 * 0.5f * d0 * (1.f + erff(d0 * 0.70710678118654752f)), c1 = ABL_PEER * g1 * 0.5f * d1 * (1.f + erff(d1 * 0.70710678118654752f));
        float acc[16];
#pragma unroll
        for (int j = 0; j < 16; ++j) acc[j] = 0.f;
#pragma unroll 1
        for (int e0 = 0; e0 < 128; e0 += 8) {
            v4u va[8], vb[8];
            const int isel = (e0 < 64) ? i0 : i1; const float csel = (e0 < 64) ? c0 : c1;
#pragma unroll
            for (int k = 0; k < 8; ++k) { const int idx = __builtin_amdgcn_readlane(isel, (e0 + k) & 63);
                const bf16* row = PV + (size_t)idx * DM; va[k] = *(const GAS v4u*)(row + 8 * lane); vb[k] = *(const GAS v4u*)(row + 512 + 8 * lane); }
#pragma unroll
            for (int k = 0; k < 8; ++k) { const float c = __builtin_bit_cast(float, __builtin_amdgcn_readlane(__builtin_bit_cast(int, csel), (e0 + k) & 63));
                AXPY8(acc, 0, va[k], c); AXPY8(acc, 8, vb[k], c); }
        }
        GAS f32x4* hp = (GAS f32x4*)(H + (size_t)t * DM + 8 * lane);
        f32x4 v[4]; v[0] = hp[0]; v[1] = hp[1]; v[2] = hp[128]; v[3] = hp[129];
        float s = 0.f;
#pragma unroll
        for (int j = 0; j < 4; ++j) { v[j] = v[j] * DN_ALPHA + (f32x4){acc[4 * j], acc[4 * j + 1], acc[4 * j + 2], acc[4 * j + 3]}; s += (v[j].x + v[j].y) + (v[j].z + v[j].w); }
        const float mean = wave_sum(s) * (1.f / DM); float s2 = 0.f;
#pragma unroll
        for (int j = 0; j < 4; ++j) { v[j] = v[j] - mean; s2 += (v[j].x * v[j].x + v[j].y * v[j].y) + (v[j].z * v[j].z + v[j].w * v[j].w); }
        const float rstd = 1.f / sqrtf(wave_sum(s2) * (1.f / DM) + LN_EPS);
#pragma unroll
        for (int j = 0; j < 4; ++j) v[j] = v[j] * rstd * gv[j] + bv[j];
        hp[0] = v[0]; hp[1] = v[1]; hp[128] = v[2]; hp[129] = v[3];
        GAS v4u* bp = (GAS v4u*)(HB + (size_t)t * DM + 8 * lane);
        bp[0] = (v4u){pk2(v[0].x, v[0].y), pk2(v[0].z, v[0].w), pk2(v[1].x, v[1].y), pk2(v[1].z, v[1].w)};
        bp[64] = (v4u){pk2(v[2].x, v[2].y), pk2(v[2].z, v[2].w), pk2(v[3].x, v[3].y), pk2(v[3].z, v[3].w)};
    }
}
#ifndef MK_SINGLE
#define MK_SINGLE 0
#endif
constexpr int NPH = 17;
#ifndef ABL_RET
#define ABL_RET 1.0f
#endif
#ifndef ABL_MLA
#define ABL_MLA 1.0f
#endif
struct Args { const void* in[21]; float* out; unsigned char* ws; int ph_lo, ph_hi; };
__global__ void __launch_bounds__(NWAVES * 64, 2) mk_fwd(Args args) {
    extern __shared__ __attribute__((aligned(16))) unsigned char lds[];
    Frame F;
    F.lds = (LAS unsigned char*)lds;
    volatile LAS unsigned* MISC = (volatile LAS unsigned*)(F.lds + MISC_OFF);
    F.tid = threadIdx.x; F.lane = F.tid & 63; F.wave = __builtin_amdgcn_readfirstlane(F.tid >> 6);
    F.G = gridDim.x; { const int bx = blockIdx.x; F.vcu = (F.G % 8 == 0) ? (bx % 8) * (F.G / 8) + bx / 8 : bx; }
    Ptrs P;
    P.x = (const float*)args.in[0]; P.pos = (const int*)args.in[1];
    P.ret_w_in = (const float*)args.in[2]; P.ret_decay = (const float*)args.in[3]; P.ret_gn_g = (const float*)args.in[4]; P.ret_gn_b = (const float*)args.in[5]; P.ret_w_out = (const float*)args.in[6];
    P.mla_w_in = (const float*)args.in[7]; P.mla_qn = (const float*)args.in[8]; P.mla_kvn = (const float*)args.in[9]; P.mla_w_uq = (const float*)args.in[10]; P.mla_w_ukv = (const float*)args.in[11]; P.mla_w_out = (const float*)args.in[12];
    P.peer_w_q = (const float*)args.in[13]; P.peer_sk = (const float*)args.in[14]; P.peer_u = (const float*)args.in[15]; P.peer_v = (const float*)args.in[16];
    P.ln_mix_g = (const float*)args.in[17]; P.ln_mix_b = (const float*)args.in[18]; P.ln_ffn_g = (const float*)args.in[19]; P.ln_ffn_b = (const float*)args.in[20];
    P.H = args.out; P.ws = args.ws;
    unsigned char* ws = args.ws;
    gu32* ctl = (gu32*)(ws + WS_CTL);
    for (int u = F.tid; u < (LDS_BYTES - LDSCTL_OFF) / 4; u += NWAVES * 64) ((LAS unsigned*)(F.lds + LDSCTL_OFF))[u] = 0u;
    __syncthreads();
    const int lo = args.ph_lo, hi = args.ph_hi;
    XcdBarrier bar; bar.bar = (unsigned*)(ctl + CW_BAR); bar.x = 0; bar.st = nullptr;
    if (hi - lo > 1) bar = xcd_barrier_post((unsigned*)(ctl + CW_BAR), MISC + 8);
#ifndef PHMASK
#define PHMASK 0x1ffff
#endif
#define IN(k) ((((PHMASK) >> (k)) & 1) && lo <= (k) && (k) < hi)
#define SEAM(k) do { if (IN(k) && IN((k) + 1)) xcd_barrier(bar); } while (0)
    bf16* HB = (bf16*)(ws + WS_HB);
    int* SELI = (int*)(ws + WS_SELI); float* SELG = (float*)(ws + WS_SELG);

    if (IN(0)) { p0_prologue(F, P); } SEAM(0);
    if (IN(1)) {
        pg8::Gemm g{HB, (const bf16*)(ws + WS_W_RIN), T, 6144, 1024}; pg8::StaticOrder S; S.init(T, 6144, F.G, (int)blockIdx.x);
        pg8::EpiRetIn E{(bf16*)(ws + WS_RQ), (bf16*)(ws + WS_RK), (bf16*)(ws + WS_RV), (bf16*)(ws + WS_RG), P.pos};
        pg8::gemm_phase<pg8::EpiRetIn, pg8::StaticOrder, true, true>(F.lds, g, S, E);
    } SEAM(1);
    if (IN(2)) {
        for (int u = F.vcu; u < 512; u += F.G) {
            const int bh = u >> 4, qb = u & 15, b = bh >> 2, h = bh & 3;
            const float lf = log1pf(-expf(P.ret_decay[h])) * 1.4426950408889634f, lb = log1pf(-expf(P.ret_decay[4 + h])) * 1.4426950408889634f;
            ret_unit(F.lds, (const bf16*)(ws + WS_RQ), (const bf16*)(ws + WS_RK), (const bf16*)(ws + WS_RV), (bf16*)(ws + WS_RG), P.ret_gn_g, P.ret_gn_b, lf, lb, b, h, qb);
        }
    } SEAM(2);
    if (IN(3)) {
        pg8::Gemm g{(const bf16*)(ws + WS_RG), (const bf16*)(ws + WS_W_ROUT), T, 1024, 2048}; pg8::StaticOrder S; S.init(T, 1024, F.G, (int)blockIdx.x);
        pg8::EpiRes E{P.x, P.H, DN_ALPHA, ABL_RET};
        pg8::gemm_phase<pg8::EpiRes, pg8::StaticOrder, true, true>(F.lds, g, S, E);
    } SEAM(3);
    if (IN(4)) { ln_rows(F, P.H, HB, P.ln_mix_g, P.ln_mix_b); } SEAM(4);
    if (IN(5)) {
        pg8::Gemm g{HB, (const bf16*)(ws + WS_W_PQ), T, 2048, 1024}; pg8::StaticOrder S; S.init(T, 2048, F.G, (int)blockIdx.x);
        pg8::EpiBf E{(bf16*)(ws + WS_QP), 2048};
        pg8::gemm_phase<pg8::EpiBf, pg8::StaticOrder, true, true>(F.lds, g, S, E);
    } SEAM(5);
    if (IN(6)) {
#ifdef TOPK_BRUTE
        for (int u = F.vcu; u < 256; u += F.G) topk_brute_unit(F.lds, (const bf16*)(ws + WS_QP), (const bf16*)(ws + WS_W_SK), SELI, SELG, u >> 3, u & 7);
#else
        for (int u = F.vcu; u < 512; u += F.G) topk_unit(F.lds, (const bf16*)(ws + WS_QP), (const bf16*)(ws + WS_W_SK), SELI, SELG, u >> 3, u & 7);
#endif
    } SEAM(6);
    if (IN(7)) { peer_gather(F, P.H, HB, SELI, SELG, (const bf16*)(ws + WS_PU), (const bf16*)(ws + WS_PV), P.ln_ffn_g, P.ln_ffn_b); } SEAM(7);
    if (IN(8)) {
        pg8::Gemm g{HB, (const bf16*)(ws + WS_W_MIN), T, 768, 1024}; pg8::StaticOrder S; S.init(T, 768, F.G, (int)blockIdx.x);
        pg8::EpiF32 E{(float*)(ws + WS_MC), 768};
        pg8::gemm_phase<pg8::EpiF32, pg8::StaticOrder, true, true>(F.lds, g, S, E);
    } SEAM(8);
    if (IN(9)) { mla_rows(F, P); } SEAM(9);
    if (IN(10)) {
        { pg8::Gemm g{(const bf16*)(ws + WS_CQN), (const bf16*)(ws + WS_W_UQ), T, 1536, 384}; pg8::StaticOrder S; S.init(T, 1536, F.G, (int)blockIdx.x);
          pg8::EpiUq E{(bf16*)(ws + WS_MQ), P.pos, MLA_QS};
          pg8::gemm_phase<pg8::EpiUq, pg8::StaticOrder, true, true>(F.lds, g, S, E); }
        { pg8::Gemm g{(const bf16*)(ws + WS_CKVN), (const bf16*)(ws + WS_W_UKV), T, 2048, 256}; pg8::StaticOrder S; S.init(T, 2048, F.G, (int)blockIdx.x);
          pg8::EpiBf E{(bf16*)(ws + WS_MKV), 2048};
          pg8::gemm_phase<pg8::EpiBf, pg8::StaticOrder, true, true>(F.lds, g, S, E); }
    } SEAM(10);
    if (IN(11)) {
        for (int u = F.vcu; u < 512; u += F.G) { const int bh = u >> 3, qb = u & 7;
            mla_unit(F.lds, (const bf16*)(ws + WS_MQ), (const bf16*)(ws + WS_MKV), (const bf16*)(ws + WS_KROPE), (bf16*)(ws + WS_MO), bh >> 3, bh & 7, qb); }
    } SEAM(11);
    if (IN(12)) {
        pg8::Gemm g{(const bf16*)(ws + WS_MO), (const bf16*)(ws + WS_W_MOUT), T, 1024, 1024}; pg8::StaticOrder S; S.init(T, 1024, F.G, (int)blockIdx.x);
        pg8::EpiRes E{P.H, P.H, DN_ALPHA, ABL_MLA};
        pg8::gemm_phase<pg8::EpiRes, pg8::StaticOrder, true, true>(F.lds, g, S, E);
    } SEAM(12);
    if (IN(13)) { ln_rows(F, P.H, HB, P.ln_mix_g + DM, P.ln_mix_b + DM); } SEAM(13);
    if (IN(14)) {
        pg8::Gemm g{HB, (const bf16*)(ws + WS_W_PQ) + (size_t)1024 * 2048, T, 2048, 1024}; pg8::StaticOrder S; S.init(T, 2048, F.G, (int)blockIdx.x);
        pg8::EpiBf E{(bf16*)(ws + WS_QP), 2048};
        pg8::gemm_phase<pg8::EpiBf, pg8::StaticOrder, true, true>(F.lds, g, S, E);
    } SEAM(14);
    if (IN(15)) {
#ifdef TOPK_BRUTE
        for (int u = F.vcu; u < 256; u += F.G) topk_brute_unit(F.lds, (const bf16*)(ws + WS_QP), (const bf16*)(ws + WS_W_SK) + (size_t)8 * 2 * 128 * 128, SELI, SELG, u >> 3, u & 7);
#else
        for (int u = F.vcu; u < 512; u += F.G) topk_unit(F.lds, (const bf16*)(ws + WS_QP), (const bf16*)(ws + WS_W_SK) + (size_t)8 * 2 * 128 * 128, SELI, SELG, u >> 3, u & 7);
#endif
    } SEAM(15);
    if (IN(16)) { peer_gather(F, P.H, HB, SELI, SELG, (const bf16*)(ws + WS_PU) + (size_t)16384 * 1024, (const bf16*)(ws + WS_PV) + (size_t)16384 * 1024, P.ln_ffn_g + DM, P.ln_ffn_b + DM); }
#undef IN
#undef SEAM
}

extern "C" void kernel_launch(void* const* d_in, const int* in_sizes, int n_in, void* d_out, int out_size, void* d_ws, size_t ws_size, hipStream_t stream) {
    static int grid = 0;
    if (grid == 0) {
        if (n_in != 21 || in_sizes[0] != T * DM || out_size != T * DM || ws_size < WS_END) { fprintf(stderr, "kernel_launch: unexpected shapes (n_in %d, in0 %d, out %d, ws %zu); nothing launched\n", n_in, n_in > 0 ? in_sizes[0] : -1, out_size, ws_size); grid = -1; return; }
        int dev = 0, cus = 0, per_cu = 0;
        if (hipGetDevice(&dev) != hipSuccess || hipDeviceGetAttribute(&cus, hipDeviceAttributeMultiprocessorCount, dev) != hipSuccess) { grid = -1; return; }
        if (hipFuncSetAttribute((const void*)mk_fwd, hipFuncAttributeMaxDynamicSharedMemorySize, LDS_BYTES) != hipSuccess) { fprintf(stderr, "kernel_launch: hipFuncSetAttribute failed\n"); grid = -1; return; }
        if (hipOccupancyMaxActiveBlocksPerMultiprocessor(&per_cu, (const void*)mk_fwd, NWAVES * 64, LDS_BYTES) != hipSuccess || per_cu < 1) { fprintf(stderr, "kernel_launch: occupancy query says %d blocks per CU\n", per_cu); }
        (void)hipGetLastError();
        grid = cus;
    }
    if (grid < 0) return;
    if (hipMemsetAsync((char*)d_ws + WS_CTL, 0, CTL_ZERO_BYTES, stream) != hipSuccess) return;
    Args a{};
    for (int i = 0; i < 21; ++i) a.in[i] = d_in[i];
    a.out = (float*)d_out; a.ws = (unsigned char*)d_ws;
#if MK_SINGLE
    a.ph_lo = 0; a.ph_hi = NPH;
    hipLaunchKernelGGL(mk_fwd, dim3(grid), dim3(NWAVES * 64), LDS_BYTES, stream, a);
#else
    for (int li = 0; li < NPH; ++li) { a.ph_lo = li; a.ph_hi = li + 1; hipLaunchKernelGGL(mk_fwd, dim3(grid), dim3(NWAVES * 64), LDS_BYTES, stream, a); }
#endif
}
```

```cpp
#include <hip/hip_runtime.h>
#include <cstdio>
#include <cstdint>
#include <cmath>
namespace pg8 {
#define PG8_LAS __attribute__((address_space(3)))
typedef unsigned short bf16_t;
typedef short bf16x8 __attribute__((ext_vector_type(8)));
typedef float f32x4 __attribute__((ext_vector_type(4)));
typedef unsigned u32x4 __attribute__((ext_vector_type(4)));
constexpr int BM = 256, BK = 64, HALF = 128, HTB = HALF * BK * 2  , STAGE_BYTES = 8 * HTB, NXCD = 8, WGM = 8;

__host__ __device__ __forceinline__ int lds_byte(int r, int c) { const int st = (r >> 4) * 2 + (c >> 5), rr = r & 15, cc = c & 31, ob = rr * 64 + cc * 2; return st * 1024 + (ob ^ (((ob >> 9) & 1) << 5)); }
__host__ __device__ __forceinline__ void stage_rc(int b, int& R, int& C) { const int st = b / 1024, sb = b % 1024, swz = sb ^ (((sb >> 9) & 1) << 5); R = (st >> 1) * 16 + swz / 64; C = (st & 1) * 32 + (swz % 64) / 2; }
__host__ __device__ __forceinline__ int perm32(int rho) { const int n = rho >> 4, i = rho & 15; return 8 * (i >> 2) + 4 * n + (i & 3); }

struct Unit { int pm, pn; };
struct Gemm { const bf16_t* A; const bf16_t* Bt; int M, N, K; };

struct StaticOrder {
    int nM, nN, nwg, G, c;
    __host__ __device__ void init(int M, int N, int G_, int c_) { nM = M / BM; nN = N / BM; nwg = nM * nN; G = G_; c = c_; }
    __host__ __device__ bool next(int i, Unit& u) const {
        const long L = (long)i * G + c; if (L >= nwg) return false;
        int wgid = (int)L; { const int q = nwg / NXCD, r = nwg % NXCD, xcd = wgid % NXCD, off = wgid / NXCD; wgid = (xcd < r ? xcd * (q + 1) : r * (q + 1) + (xcd - r) * q) + off; }
        const int nig = WGM * nN, gid = wgid / nig, fm = gid * WGM, gsz = (nM - fm) < WGM ? (nM - fm) : WGM;
        u.pm = fm + ((wgid % nig) % gsz); u.pn = (wgid % nig) / gsz; return true;
    }
    __device__ __forceinline__ void a_ready(const Unit&) const {}
    __device__ __forceinline__ void done(const Unit&) const {}
};

typedef float f32x2_cv __attribute__((ext_vector_type(2))); typedef __bf16 bf16x2_cv __attribute__((ext_vector_type(2)));
__device__ __forceinline__ unsigned cvt_pk_bf16(float lo, float hi) { f32x2_cv v = {lo, hi}; bf16x2_cv b = __builtin_convertvector(v, bf16x2_cv); return __builtin_bit_cast(unsigned, b); }
typedef float f32x2 __attribute__((ext_vector_type(2)));
__device__ __forceinline__ u32x4 pack8(const f32x4 a, const f32x4 b, float sc) {
    u32x4 w; w.x = cvt_pk_bf16(a[0] * sc, a[1] * sc); w.y = cvt_pk_bf16(a[2] * sc, a[3] * sc); w.z = cvt_pk_bf16(b[0] * sc, b[1] * sc); w.w = cvt_pk_bf16(b[2] * sc, b[3] * sc); return w;
}
struct EpiRetIn {
    static constexpr bool PERM = true, AFTER_DRAIN = false;
    bf16_t *Q, *Kb, *V, *G; const int* pos;
    __device__ __forceinline__ void operator()(const f32x4 (&acc)[2][2][4][2], const Unit& u, int wr, int wc, int fr, int fq) const {
        const int row0 = u.pm * BM + wr * 64 + fr;
        if (u.pn < 8) {
            bf16_t* base = (u.pn < 4) ? Q : Kb; const int head = u.pn & 3; const float sc = (u.pn < 4) ? 1.0f : 0.0625f;
            const int i0 = wc * 32 + 8 * fq;
            float fv[8];
#pragma unroll
            for (int j = 0; j < 8; ++j) fv[j] = __builtin_amdgcn_exp2f(-(float)(i0 + j) * (13.287712379549449f / 128.0f)) * 0.15915494309189535f;
#pragma unroll
            for (int ai = 0; ai < 2; ++ai)
#pragma unroll
                for (int m = 0; m < 4; ++m) {
                    const int row = row0 + ai * HALF + m * 16; const float p = (float)pos[row];
                    f32x4 o1[2], o2[2];
#pragma unroll
                    for (int n = 0; n < 2; ++n)
#pragma unroll
                        for (int e = 0; e < 4; ++e) {
                            float a = p * fv[4 * n + e]; a = __builtin_amdgcn_fractf(a);
                            const float s = __builtin_amdgcn_sinf(a), c = __builtin_amdgcn_cosf(a);
                            const float x1 = acc[ai][0][m][n][e], x2 = acc[ai][1][m][n][e];
                            o1[n][e] = x1 * c - x2 * s; o2[n][e] = x1 * s + x2 * c;
                        }
                    bf16_t* rp = base + (size_t)row * 1024 + head * 256 + i0;
                    *(u32x4*)rp = pack8(o1[0], o1[1], sc); *(u32x4*)(rp + 128) = pack8(o2[0], o2[1], sc);
                    asm volatile("" ::: "memory");
                }
        } else {
            bf16_t* base = (u.pn < 16) ? V : G; const int ct = (u.pn < 16) ? u.pn - 8 : u.pn - 16;
            const int col0 = ct * BM + wc * 32 + 8 * fq;
#pragma unroll
            for (int ai = 0; ai < 2; ++ai)
#pragma unroll
                for (int m = 0; m < 4; ++m) {
                    bf16_t* rp = base + (size_t)(row0 + ai * HALF + m * 16) * 2048 + col0;
#pragma unroll
                    for (int bj = 0; bj < 2; ++bj) *(u32x4*)(rp + bj * HALF) = pack8(acc[ai][bj][m][0], acc[ai][bj][m][1], 1.0f);
                }
        }
    }
};
struct EpiRes {
    static constexpr bool PERM = true, AFTER_DRAIN = false;
    const float* base; float* out; float alpha; float mixs;
    __device__ __forceinline__ void operator()(const f32x4 (&acc)[2][2][4][2], const Unit& u, int wr, int wc, int fr, int fq) const {
        const int row0 = u.pm * BM + wr * 64 + fr, col0 = u.pn * BM + wc * 32 + 8 * fq;
#pragma unroll
        for (int ai = 0; ai < 2; ++ai)
#pragma unroll
            for (int m = 0; m < 4; ++m) {
                const size_t off = (size_t)(row0 + ai * HALF + m * 16) * 1024 + col0;
#pragma unroll
                for (int bj = 0; bj < 2; ++bj)
#pragma unroll
                    for (int n = 0; n < 2; ++n) { const f32x4 b = *(const f32x4*)(base + off + bj * HALF + 4 * n); *(f32x4*)(out + off + bj * HALF + 4 * n) = b * alpha + acc[ai][bj][m][n] * mixs; }
            }
    }
};
struct EpiF32 {
    static constexpr bool PERM = true, AFTER_DRAIN = false;
    float* C; int ldc;
    __device__ __forceinline__ void operator()(const f32x4 (&acc)[2][2][4][2], const Unit& u, int wr, int wc, int fr, int fq) const {
        const int row0 = u.pm * BM + wr * 64 + fr, col0 = u.pn * BM + wc * 32 + 8 * fq;
#pragma unroll
        for (int ai = 0; ai < 2; ++ai)
#pragma unroll
            for (int m = 0; m < 4; ++m) {
                const size_t off = (size_t)(row0 + ai * HALF + m * 16) * ldc + col0;
#pragma unroll
                for (int bj = 0; bj < 2; ++bj)
#pragma unroll
                    for (int n = 0; n < 2; ++n) *(f32x4*)(C + off + bj * HALF + 4 * n) = acc[ai][bj][m][n];
            }
    }
};
struct EpiBf {
    static constexpr bool PERM = true, AFTER_DRAIN = false;
    bf16_t* O; int ldc;
    __device__ __forceinline__ void operator()(const f32x4 (&acc)[2][2][4][2], const Unit& u, int wr, int wc, int fr, int fq) const {
        const int row0 = u.pm * BM + wr * 64 + fr, col0 = u.pn * BM + wc * 32 + 8 * fq;
#pragma unroll
        for (int ai = 0; ai < 2; ++ai)
#pragma unroll
            for (int m = 0; m < 4; ++m) {
                bf16_t* rp = O + (size_t)(row0 + ai * HALF + m * 16) * ldc + col0;
#pragma unroll
                for (int bj = 0; bj < 2; ++bj) *(u32x4*)(rp + bj * HALF) = pack8(acc[ai][bj][m][0], acc[ai][bj][m][1], 1.0f);
            }
    }
};
struct EpiUq {
    static constexpr bool PERM = true, AFTER_DRAIN = false;
    bf16_t* O; const int* pos; float qs;
    __device__ __forceinline__ void operator()(const f32x4 (&acc)[2][2][4][2], const Unit& u, int wr, int wc, int fr, int fq) const {
        const int row0 = u.pm * BM + wr * 64 + fr, col0 = u.pn * BM + wc * 32 + 8 * fq;
        if (u.pn < 4) {
#pragma unroll
            for (int ai = 0; ai < 2; ++ai)
#pragma unroll
                for (int m = 0; m < 4; ++m) {
                    bf16_t* rp = O + (size_t)(row0 + ai * HALF + m * 16) * 1536 + col0;
#pragma unroll
                    for (int bj = 0; bj < 2; ++bj) *(u32x4*)(rp + bj * HALF) = pack8(acc[ai][bj][m][0], acc[ai][bj][m][1], qs);
                }
        } else {
            float fv[8];
#pragma unroll
            for (int j = 0; j < 8; ++j) fv[j] = __builtin_amdgcn_exp2f(-(float)(8 * fq + j) * (13.287712379549449f / 32.0f)) * 0.15915494309189535f;
#pragma unroll
            for (int ai = 0; ai < 2; ++ai)
#pragma unroll
                for (int m = 0; m < 4; ++m) {
                    const int row = row0 + ai * HALF + m * 16; const float p = (float)pos[row];
                    f32x4 o1[2], o2[2];
#pragma unroll
                    for (int n = 0; n < 2; ++n)
#pragma unroll
                        for (int e = 0; e < 4; ++e) {
                            float a = p * fv[4 * n + e]; a = __builtin_amdgcn_fractf(a);
                            const float s = __builtin_amdgcn_sinf(a), c = __builtin_amdgcn_cosf(a);
                            const float x1 = acc[ai][0][m][n][e], x2 = acc[ai][1][m][n][e];
                            o1[n][e] = x1 * c - x2 * s; o2[n][e] = x1 * s + x2 * c;
                        }
                    bf16_t* rp = O + (size_t)row * 1536 + col0;
                    *(u32x4*)rp = pack8(o1[0], o1[1], qs); *(u32x4*)(rp + 128) = pack8(o2[0], o2[1], qs);
                    asm volatile("" ::: "memory");
                }
        }
    }
};
template <class Epi, class Sched, bool ALIGN_EPI = false, bool SP2 = false>
__device__ __forceinline__ void gemm_phase(PG8_LAS unsigned char* lds, const Gemm g, const Sched& S, const Epi& E) {
    const int tid = threadIdx.x, wid = __builtin_amdgcn_readfirstlane(tid >> 6), lane = tid & 63, wr = wid >> 2, wc = wid & 3, fr = lane & 15, fq = lane >> 4;
    const int K = g.K, nt = K / BK;
    unsigned voffA[2], voffB[2];
#pragma unroll
    for (int i = 0; i < 2; ++i) { int R, C; stage_rc(tid * 16 + i * 8192, R, C); const int Rb = Epi::PERM ? ((R & ~31) + perm32(R & 31)) : R;
        voffA[i] = (unsigned)(R * K + C) * 2u; voffB[i] = (unsigned)(Rb * K + C) * 2u; }
    const size_t kstep = (size_t)(BK * 2);
    const size_t hstep = (size_t)HALF * K * 2;
    const size_t tstep = 2 * hstep;
    const unsigned ldsw = (unsigned)wid * 1024u;
    const int aoff = lds_byte(wr * 64 + fr, fq * 8), boff = lds_byte(wc * 32 + fr, fq * 8);
#define PG8_SA(b, h) (((b) * 2 + (h)) * HTB)
#define PG8_SB(b, h) ((4 + (b) * 2 + (h)) * HTB)
#define PG8_STAGE(bufoff, gbase, voff) do { _Pragma("unroll") for (int _i = 0; _i < 2; ++_i) \
        __builtin_amdgcn_global_load_lds((const unsigned*)((const char*)(gbase) + (voff)[_i]), (PG8_LAS unsigned*)(lds + (bufoff) + ldsw + _i * 8192), 16, 0, 0); } while (0)
#define PG8_LDA(dst, b, h) do { _Pragma("unroll") for (int m = 0; m < 4; ++m) _Pragma("unroll") for (int k = 0; k < 2; ++k) dst[m][k] = *(const PG8_LAS bf16x8*)(lds + PG8_SA(b, h) + aoff + m * 2048 + k * 1024); } while (0)
#define PG8_LDB(dst, b, h) do { _Pragma("unroll") for (int n = 0; n < 2; ++n) _Pragma("unroll") for (int k = 0; k < 2; ++k) dst[n][k] = *(const PG8_LAS bf16x8*)(lds + PG8_SB(b, h) + boff + n * 2048 + k * 1024); } while (0)
#define PG8_MMA(ai, bj, At, Bt) do { __builtin_amdgcn_s_setprio(1); _Pragma("unroll") for (int m = 0; m < 4; ++m) _Pragma("unroll") for (int n = 0; n < 2; ++n) _Pragma("unroll") for (int k = 0; k < 2; ++k) \
        acc[ai][bj][m][n] = __builtin_amdgcn_mfma_f32_16x16x32_bf16(Bt[n][k], At[m][k], acc[ai][bj][m][n], 0, 0, 0); __builtin_amdgcn_s_setprio(0); } while (0)
#define PG8_WAIT_V(n) asm volatile("s_waitcnt vmcnt(" #n ")" ::: "memory")
#define PG8_WAIT_L(n) asm volatile("s_waitcnt lgkmcnt(" #n ")" ::: "memory")
#define PG8_BAR __builtin_amdgcn_s_barrier()
#define PG8_SCHED __builtin_amdgcn_sched_barrier(0)
    Unit cur, nxt; int ui = 0;
    if (!S.next(0, cur)) return;
    f32x4 acc[2][2][4][2];
#pragma unroll
    for (int a = 0; a < 2; ++a)
#pragma unroll
        for (int b = 0; b < 2; ++b)
#pragma unroll
            for (int m = 0; m < 4; ++m)
#pragma unroll
                for (int n = 0; n < 2; ++n) acc[a][b][m][n] = (f32x4){0.f, 0.f, 0.f, 0.f};
    bf16x8 At[4][2], B0[2][2], B1[2][2];
    const char* cA = (const char*)g.A + (size_t)cur.pm * tstep; const char* cB = (const char*)g.Bt + (size_t)cur.pn * tstep;
    S.a_ready(cur);
    if constexpr (SP2) {
        PG8_STAGE(PG8_SB(0, 0), cB, voffB); PG8_STAGE(PG8_SB(0, 1), cB + hstep, voffB); PG8_STAGE(PG8_SA(0, 0), cA, voffA); PG8_STAGE(PG8_SA(0, 1), cA + hstep, voffA);
        if (wr == 1) PG8_BAR;
        PG8_WAIT_V(2); PG8_BAR;
        PG8_STAGE(PG8_SB(1, 0), cB + kstep, voffB); PG8_STAGE(PG8_SA(1, 0), cA + kstep, voffA); PG8_STAGE(PG8_SB(1, 1), cB + hstep + kstep, voffB);
        PG8_WAIT_V(6); PG8_BAR;
    } else {
        PG8_STAGE(PG8_SB(0, 0), cB, voffB); PG8_STAGE(PG8_SA(0, 0), cA, voffA); PG8_STAGE(PG8_SB(0, 1), cB + hstep, voffB); PG8_STAGE(PG8_SA(0, 1), cA + hstep, voffA);
        if (wr == 1) PG8_BAR;
        PG8_WAIT_V(4); PG8_BAR;
        PG8_STAGE(PG8_SB(1, 0), cB + kstep, voffB); PG8_STAGE(PG8_SA(1, 0), cA + kstep, voffA); PG8_STAGE(PG8_SB(1, 1), cB + hstep + kstep, voffB);
        PG8_WAIT_V(6); PG8_BAR;
    }
    for (;;) {
        const bool has_next = S.next(ui + 1, nxt);
        const char* nA = has_next ? (const char*)g.A + (size_t)nxt.pm * tstep : cA; const char* nB = has_next ? (const char*)g.Bt + (size_t)nxt.pn * tstep : cB;
#pragma unroll 1
        for (int t = 0; t < nt; t += 2) {
            const bool last = (t == nt - 2);
            const char* a1 = cA + (size_t)(t + 1) * kstep;
            const char* a2 = last ? nA : cA + (size_t)(t + 2) * kstep; const char* b2 = last ? nB : cB + (size_t)(t + 2) * kstep;
            const char* a3 = a2 + kstep; const char* b3 = b2 + kstep;
            if (last && has_next) S.a_ready(nxt);
            if constexpr (SP2) {
            PG8_LDB(B0, 0, 0); PG8_LDB(B1, 0, 1); PG8_SCHED; PG8_LDA(At, 0, 0); PG8_STAGE(PG8_SA(1, 1), a1 + hstep, voffA);
            PG8_WAIT_V(8); PG8_WAIT_L(0); PG8_BAR; PG8_MMA(0, 0, At, B0); PG8_MMA(0, 1, At, B1); PG8_BAR; PG8_SCHED;
            PG8_LDA(At, 0, 1); PG8_STAGE(PG8_SB(0, 0), b2, voffB); PG8_STAGE(PG8_SB(0, 1), b2 + hstep, voffB); PG8_STAGE(PG8_SA(0, 0), a2, voffA);
            PG8_WAIT_V(8); PG8_WAIT_L(0); PG8_BAR; PG8_MMA(1, 0, At, B0); PG8_MMA(1, 1, At, B1); PG8_BAR; PG8_SCHED;
            PG8_LDB(B0, 1, 0); PG8_LDB(B1, 1, 1); PG8_SCHED; PG8_LDA(At, 1, 0); PG8_STAGE(PG8_SA(0, 1), a2 + hstep, voffA);
            PG8_WAIT_V(8); PG8_WAIT_L(0); PG8_BAR; PG8_MMA(0, 0, At, B0); PG8_MMA(0, 1, At, B1); PG8_BAR; PG8_SCHED;
            PG8_LDA(At, 1, 1); PG8_STAGE(PG8_SB(1, 0), b3, voffB); PG8_STAGE(PG8_SB(1, 1), b3 + hstep, voffB); PG8_STAGE(PG8_SA(1, 0), a3, voffA);
            PG8_WAIT_V(8); PG8_WAIT_L(0); PG8_BAR; PG8_MMA(1, 0, At, B0); PG8_MMA(1, 1, At, B1); PG8_BAR; PG8_SCHED;
            } else {
            PG8_LDB(B0, 0, 0); PG8_SCHED; PG8_LDA(At, 0, 0); PG8_STAGE(PG8_SA(1, 1), a1 + hstep, voffA);
            PG8_WAIT_L(8); PG8_BAR; PG8_WAIT_L(0); PG8_MMA(0, 0, At, B0); PG8_BAR; PG8_SCHED;
            PG8_LDB(B1, 0, 1); PG8_STAGE(PG8_SB(0, 0), b2, voffB);
            PG8_BAR; PG8_WAIT_L(0); PG8_MMA(0, 1, At, B1); PG8_BAR;
            PG8_LDA(At, 0, 1); PG8_STAGE(PG8_SA(0, 0), a2, voffA);
            PG8_BAR; PG8_WAIT_L(0); PG8_MMA(1, 0, At, B0); PG8_BAR; PG8_SCHED;
            PG8_STAGE(PG8_SB(0, 1), b2 + hstep, voffB);
            PG8_WAIT_V(6); PG8_BAR; PG8_MMA(1, 1, At, B1); PG8_BAR;
            PG8_LDB(B0, 1, 0); PG8_SCHED; PG8_LDA(At, 1, 0); PG8_STAGE(PG8_SA(0, 1), a2 + hstep, voffA);
            PG8_WAIT_L(8); PG8_BAR; PG8_WAIT_L(0); PG8_MMA(0, 0, At, B0); PG8_BAR; PG8_SCHED;
            PG8_LDB(B1, 1, 1); PG8_STAGE(PG8_SB(1, 0), b3, voffB);
            PG8_BAR; PG8_WAIT_L(0); PG8_MMA(0, 1, At, B1); PG8_BAR;
            PG8_LDA(At, 1, 1); PG8_STAGE(PG8_SA(1, 0), a3, voffA);
            PG8_BAR; PG8_WAIT_L(0); PG8_MMA(1, 0, At, B0); PG8_BAR; PG8_SCHED;
            PG8_STAGE(PG8_SB(1, 1), b3 + hstep, voffB);
            PG8_WAIT_V(6); PG8_BAR; PG8_MMA(1, 1, At, B1); PG8_BAR;
            }
        }
        if constexpr (ALIGN_EPI) { if (wr == 0) PG8_BAR; }
        if constexpr (!Epi::AFTER_DRAIN) { E(acc, cur, wr, wc, fr, fq); S.done(cur); }
        if (!has_next) break;
#pragma unroll
        for (int a = 0; a < 2; ++a)
#pragma unroll
            for (int b = 0; b < 2; ++b)
#pragma unroll
                for (int m = 0; m < 4; ++m)
#pragma unroll
                    for (int n = 0; n < 2; ++n) acc[a][b][m][n] = (f32x4){0.f, 0.f, 0.f, 0.f};
        cur = nxt; cA = nA; cB = nB; ++ui;
        if constexpr (ALIGN_EPI) { if (wr == 1) PG8_BAR; }
    }
    PG8_WAIT_V(0);
    if constexpr (!ALIGN_EPI) { if (wr == 0) PG8_BAR; }
    PG8_BAR;
    if constexpr (Epi::AFTER_DRAIN) { E.fused(acc, cur, wr, wc, fr, fq, lds, wid, lane); S.done(cur); }
#undef PG8_SA
#undef PG8_SB
#undef PG8_STAGE
#undef PG8_LDA
#undef PG8_LDB
#undef PG8_MMA
#undef PG8_WAIT_V
#undef PG8_WAIT_L
#undef PG8_BAR
#undef PG8_SCHED
}
}
#define GAS __attribute__((address_space(1)))
#define LAS __attribute__((address_space(3)))
typedef unsigned short bf16;
typedef unsigned v4u __attribute__((ext_vector_type(4)));
typedef float f32x4 __attribute__((ext_vector_type(4)));
typedef short bf16x8 __attribute__((ext_vector_type(8)));
typedef GAS unsigned gu32;
typedef GAS unsigned long long gu64;
#define RLX_AGENT __ATOMIC_RELAXED, __HIP_MEMORY_SCOPE_AGENT
#define LDS_WAIT() asm volatile("s_waitcnt lgkmcnt(0)" ::: "memory")
#define VM_WAIT() asm volatile("s_waitcnt vmcnt(0)" ::: "memory")
__device__ __forceinline__ unsigned long long rt() { return __builtin_amdgcn_s_memrealtime(); }
__device__ __forceinline__ unsigned f2bf(float f) { unsigned u = __builtin_bit_cast(unsigned, f); return (u + 0x7fffu + ((u >> 16) & 1u)) >> 16; }
__device__ __forceinline__ unsigned pk2(float lo, float hi) { return f2bf(lo) | (f2bf(hi) << 16); }
#define XB_TMO      128
#define XB_XCNT(j)  (256  + 64 * (j))
#define XB_XSUB(j)  (1280 + 64 * (j))
#define XB_XGEN(j)  (2304 + 64 * (j))
#define XB_TOP      3328
#define XB_TOPGEN   3392
#define XCD_BAR_WORDS 3456
#define XB_SPIN_CAP (1u << 18)

__device__ __forceinline__ unsigned xb_ld(unsigned* p)              { return __hip_atomic_load(p, __ATOMIC_RELAXED, __HIP_MEMORY_SCOPE_AGENT); }
__device__ __forceinline__ unsigned xb_add(unsigned* p, unsigned v) { return __hip_atomic_fetch_add(p, v, __ATOMIC_RELAXED, __HIP_MEMORY_SCOPE_AGENT); }
__device__ __forceinline__ unsigned xb_xcc_id() { return (unsigned)__builtin_amdgcn_s_getreg((3 << 11) | 20) & 0xFu; }
#define XB_SPIN(cond, bar) do { unsigned _sp = 0; while (cond) { __builtin_amdgcn_s_sleep(1); \
    if ((++_sp & 255u) == 0u) { if (xb_ld(&(bar)[XB_TMO])) break; if (_sp > XB_SPIN_CAP) { atomicAdd(&(bar)[XB_TMO], 1u); break; } } } } while (0)

struct XcdBarrier {
    unsigned* bar; unsigned x;
    volatile LAS unsigned* st;
};

__device__ __forceinline__ XcdBarrier xcd_barrier_post(unsigned* bar, volatile LAS unsigned* st) {
    XcdBarrier b; b.bar = bar; b.x = xb_xcc_id(); b.st = st;
    if (threadIdx.x == 0) (void)xb_add(&bar[XB_XCNT(b.x)], 1u);
    return b;
}
__device__ __forceinline__ void xcd_barrier_complete(unsigned* bar, unsigned x, unsigned& nloc, unsigned& nx) {
    const unsigned G = gridDim.x * gridDim.y * gridDim.z;
    unsigned sum, cnt, mine, sp = 0u;
    for (;;) {
        sum = 0u; cnt = 0u; mine = 0u;
#pragma unroll
        for (unsigned j = 0; j < 16; ++j) { const unsigned c = xb_ld(&bar[XB_XCNT(j)]); sum += c; cnt += (c > 0u) ? 1u : 0u; mine = (j == x) ? c : mine; }
        if (sum == G) break;
        __builtin_amdgcn_s_sleep(1);
        if ((++sp & 255u) == 0u) { if (xb_ld(&bar[XB_TMO])) break; if (sp > XB_SPIN_CAP) { atomicAdd(&bar[XB_TMO], 1u); break; } }
    }
    nloc = mine > 0u ? mine : 1u; nx = cnt > 0u ? cnt : 1u;
}

__device__ __forceinline__ void xcd_barrier(const XcdBarrier& b) {
    asm volatile("s_waitcnt vmcnt(0)" ::: "memory");
    __syncthreads();
    if (threadIdx.x == 0) {
        unsigned* bar = b.bar;
        __builtin_amdgcn_s_waitcnt(0);
        unsigned nloc = b.st[0], nx = b.st[1];
        if (nloc == 0u) { xcd_barrier_complete(bar, b.x, nloc, nx); b.st[0] = nloc; b.st[1] = nx; }
        const unsigned old = xb_add(&bar[XB_XSUB(b.x)], 1u);
        const unsigned gen = old / nloc;
        if (old + 1u == (gen + 1u) * nloc) {
            __builtin_amdgcn_fence(__ATOMIC_RELEASE, "agent");
            asm volatile("s_waitcnt vmcnt(0)" ::: "memory");
            const unsigned og = xb_add(&bar[XB_TOP], 1u);
            const unsigned tg = og / nx;
            if (og + 1u == (tg + 1u) * nx) xb_add(&bar[XB_TOPGEN], 1u);
            else XB_SPIN(xb_ld(&bar[XB_TOPGEN]) == tg, bar);
            __builtin_amdgcn_fence(__ATOMIC_ACQUIRE, "agent");
            xb_add(&bar[XB_XGEN(b.x)], 1u);
            asm volatile("s_waitcnt vmcnt(0)" ::: "memory");
        } else {
            XB_SPIN(xb_ld(&bar[XB_XGEN(b.x)]) == gen, bar);
            __builtin_amdgcn_fence(__ATOMIC_ACQUIRE, "agent");
            asm volatile("s_waitcnt vmcnt(0)" ::: "memory");
        }
    }
    __syncthreads();
}
constexpr int NWAVES = 8;
constexpr int BATCH = 8, SEQ = 2048, DM = 1024, T = BATCH * SEQ;
constexpr float LN_EPS = 1e-5f, DN_ALPHA = 1.4142135623730951f;
constexpr float MLA_QS = 0.07216878364870322f * 1.4426950408889634f;
constexpr size_t MiB = 1u << 20;
constexpr size_t WS_CTL = 0, CTL_ZERO_BYTES = 1 * MiB;
constexpr size_t WS_W_RIN = 1 * MiB, WS_W_ROUT = 13 * MiB, WS_W_MIN = 17 * MiB, WS_W_UQ = 19 * MiB, WS_W_UKV = 21 * MiB, WS_W_MOUT = 22 * MiB, WS_W_PQ = 24 * MiB, WS_W_SK = 32 * MiB;
constexpr size_t WS_PU = 33 * MiB, WS_PV = 97 * MiB, WS_HB = 161 * MiB, WS_SELI = 193 * MiB, WS_SELG = 201 * MiB;
constexpr size_t WS_ACT = 209 * MiB;
constexpr size_t WS_RQ = WS_ACT, WS_RK = WS_ACT + 32 * MiB, WS_RV = WS_ACT + 64 * MiB, WS_RG = WS_ACT + 128 * MiB;
constexpr size_t WS_QP = WS_ACT;
constexpr size_t WS_MC = WS_ACT, WS_CQN = WS_ACT + 48 * MiB, WS_CKVN = WS_ACT + 60 * MiB, WS_KROPE = WS_ACT + 68 * MiB, WS_MQ = WS_ACT + 70 * MiB, WS_MKV = WS_ACT + 118 * MiB, WS_MO = WS_ACT + 182 * MiB;
constexpr size_t WS_END = WS_ACT + 214 * MiB;
constexpr int CW_BAR = 4096;
constexpr int RING_BYTES = 131072, LDSCTL_OFF = RING_BYTES, MISC_OFF = LDSCTL_OFF + 320, LDS_BYTES = 163840;

__device__ __forceinline__ float bf2f(bf16 v) { return __builtin_bit_cast(float, (unsigned)v << 16); }
__device__ __forceinline__ float wave_sum(float v) {
#pragma unroll
    for (int o = 1; o < 64; o <<= 1) v += __shfl_xor(v, o);
    return v;
}
__device__ __forceinline__ float vmaxf(float a, float b) { return __builtin_fmaxf(a, b); }
__device__ __forceinline__ float vminf(float a, float b) { return __builtin_fminf(a, b); }
typedef float f32x16 __attribute__((ext_vector_type(16)));
typedef short s16x4 __attribute__((ext_vector_type(4)));
__device__ __forceinline__ int crow0(int r) { return (r & 3) + 8 * (r >> 2); }
__device__ __forceinline__ s16x4 vtr(const LAS unsigned char* p) { return __builtin_bit_cast(s16x4, __builtin_amdgcn_ds_read_tr16_b64_v4i16((LAS s16x4*)p)); }

struct Frame {
    LAS unsigned char* lds;
    int tid, lane, wave, vcu, G;
};

template <int NMAP>
__device__ __forceinline__ void p0_transpose_item(const float* W, int K, int N, bf16* WT, LAS float* scr, int item, int lane) {
    const int nblk = N / 32, kb = item / nblk, nb = item % nblk, k0 = 64 * kb, n0 = 32 * nb;
    int no = n0;
    if (NMAP == 1) { const int h = n0 / 192, d0 = n0 % 192; no = (d0 < 128) ? (h * 128 + d0) : (1024 + 256 * (h >> 2) + (h & 3) * 32 + (d0 == 160 ? 128 : 0)); }
#pragma unroll 8
    for (int i = 0; i < 32; ++i) { const int kk = 2 * i + (lane >> 5); scr[kk * 33 + (lane & 31)] = W[(size_t)(k0 + kk) * N + n0 + (lane & 31)]; }
    LDS_WAIT(); asm volatile("" ::: "memory");
    const int c = lane & 7;
#pragma unroll
    for (int j = 0; j < 4; ++j) { const int n = (lane >> 3) + 8 * j; const LAS float* s = scr + (8 * c) * 33 + n;
        v4u o; o.x = pk2(s[0 * 33], s[1 * 33]); o.y = pk2(s[2 * 33], s[3 * 33]); o.z = pk2(s[4 * 33], s[5 * 33]); o.w = pk2(s[6 * 33], s[7 * 33]);
        *(GAS v4u*)(WT + (size_t)(no + n) * K + k0 + 8 * c) = o; }
    LDS_WAIT(); asm volatile("" ::: "memory");
}
__device__ __forceinline__ void cvt_range(const float* src, bf16* dst, size_t n, int gw, int NGW, int lane) {
    const size_t nchunk = n / 2048;
    for (size_t c = gw; c < nchunk; c += NGW) {
        const float* s = src + c * 2048 + lane * 8; bf16* d = dst + c * 2048 + lane * 8;
        f32x4 a[4], b[4];
#pragma unroll
        for (int j = 0; j < 4; ++j) { a[j] = *(const GAS f32x4*)(s + j * 512); b[j] = *(const GAS f32x4*)(s + j * 512 + 4); }
#pragma unroll
        for (int j = 0; j < 4; ++j) { v4u o; o.x = pk2(a[j][0], a[j][1]); o.y = pk2(a[j][2], a[j][3]); o.z = pk2(b[j][0], b[j][1]); o.w = pk2(b[j][2], b[j][3]); *(GAS v4u*)(d + j * 512) = o; }
    }
}
__device__ __forceinline__ void cvt_range_fp8(const float* src, unsigned char* dst, size_t n, float scale, int gw, int NGW, int lane) {
    const size_t nchunk = n / 4096;
    for (size_t c = gw; c < nchunk; c += NGW) {
        f32x4 a[16];
#pragma unroll
        for (int j = 0; j < 16; ++j) a[j] = *(const GAS f32x4*)(src + c * 4096 + j * 256 + lane * 4);
#pragma unroll
        for (int j = 0; j < 16; ++j) { unsigned w = __builtin_amdgcn_cvt_pk_fp8_f32(a[j][0] * scale, a[j][1] * scale, 0, false); w = __builtin_amdgcn_cvt_pk_fp8_f32(a[j][2] * scale, a[j][3] * scale, w, true);
            *(GAS unsigned*)(dst + c * 4096 + j * 256 + lane * 4) = w; }
    }
}
struct Ptrs {
    const float *x; const int* pos;
    const float *ret_w_in, *ret_decay, *ret_gn_g, *ret_gn_b, *ret_w_out, *mla_w_in, *mla_qn, *mla_kvn, *mla_w_uq, *mla_w_ukv, *mla_w_out, *peer_w_q, *peer_sk, *peer_u, *peer_v, *ln_mix_g, *ln_mix_b, *ln_ffn_g, *ln_ffn_b;
    float* H; unsigned char* ws;
};
__device__ __forceinline__ void p0_prologue(const Frame& F, const Ptrs& P) {
    LAS float* scr = (LAS float*)(F.lds + F.wave * 16384);
    const int gw = F.vcu * NWAVES + F.wave, NGW = F.G * NWAVES;
    unsigned char* ws = P.ws;
    constexpr int I0 = 16 * 192, I1 = 32 * 32, I2 = 16 * 22, I3 = 6 * 48, I4 = 4 * 64, I5 = 16 * 32, I6 = 16 * 64;
    constexpr int NITEMS = I0 + I1 + I2 + I3 + I4 + I5 + 2 * I6;
    for (int it = gw; it < NITEMS; it += NGW) {
        int r = it;
        if (r < I0) { p0_transpose_item<0>(P.ret_w_in, 1024, 6144, (bf16*)(ws + WS_W_RIN), scr, r, F.lane); continue; } r -= I0;
        if (r < I1) { p0_transpose_item<0>(P.ret_w_out, 2048, 1024, (bf16*)(ws + WS_W_ROUT), scr, r, F.lane); continue; } r -= I1;
        if (r < I2) { p0_transpose_item<0>(P.mla_w_in, 1024, 704, (bf16*)(ws + WS_W_MIN), scr, r, F.lane); continue; } r -= I2;
        if (r < I3) { p0_transpose_item<1>(P.mla_w_uq, 384, 1536, (bf16*)(ws + WS_W_UQ), scr, r, F.lane); continue; } r -= I3;
        if (r < I4) { p0_transpose_item<0>(P.mla_w_ukv, 256, 2048, (bf16*)(ws + WS_W_UKV), scr, r, F.lane); continue; } r -= I4;
        if (r < I5) { p0_transpose_item<0>(P.mla_w_out, 1024, 1024, (bf16*)(ws + WS_W_MOUT), scr, r, F.lane); continue; } r -= I5;
        if (r < I6) { p0_transpose_item<0>(P.peer_w_q, 1024, 2048, (bf16*)(ws + WS_W_PQ), scr, r, F.lane); continue; } r -= I6;
        p0_transpose_item<0>(P.peer_w_q + (size_t)1024 * 2048, 1024, 2048, (bf16*)(ws + WS_W_PQ) + (size_t)1024 * 2048, scr, r, F.lane);
    }
    for (int c = gw; c < 32; c += NGW) { GAS v4u* d = (GAS v4u*)((bf16*)(ws + WS_W_MIN) + (size_t)704 * 1024 + c * 2048) + F.lane * 4;
#pragma unroll
        for (int j = 0; j < 4; ++j) d[j] = (v4u){0u, 0u, 0u, 0u}; }
    cvt_range(P.peer_sk, (bf16*)(ws + WS_W_SK), (size_t)2 * 8 * 2 * 128 * 128, gw, NGW, F.lane);
    cvt_range(P.x, (bf16*)(ws + WS_HB), (size_t)T * DM, gw, NGW, F.lane);
}

__device__ __forceinline__ void ln_rows(const Frame& F, const float* H, bf16* HB, const float* g, const float* b, float* STAT) {
    const int gw = F.vcu * NWAVES + F.wave, NGW = F.G * NWAVES;
    f32x4 gv[4], bv[4];
#pragma unroll
    for (int j = 0; j < 4; ++j) { gv[j] = *(const GAS f32x4*)(g + 4 * F.lane + 256 * j); bv[j] = *(const GAS f32x4*)(b + 4 * F.lane + 256 * j); }
    for (int m = gw; m < T; m += NGW) {
        const GAS f32x4* xr = (const GAS f32x4*)(H + (size_t)m * DM) + F.lane;
        f32x4 v[4]; float s = 0.f;
#pragma unroll
        for (int j = 0; j < 4; ++j) { v[j] = xr[64 * j]; s += (v[j].x + v[j].y) + (v[j].z + v[j].w); }
        const float mean = wave_sum(s) * (1.f / DM); float s2 = 0.f;
#pragma unroll
        for (int j = 0; j < 4; ++j) { v[j] = v[j] - mean; s2 += (v[j].x * v[j].x + v[j].y * v[j].y) + (v[j].z * v[j].z + v[j].w * v[j].w); }
        const float rstd = 1.f / sqrtf(wave_sum(s2) * (1.f / DM) + LN_EPS);
        GAS unsigned long long* o8 = (GAS unsigned long long*)(HB + (size_t)m * DM) + F.lane;
        if (F.lane == 0) { STAT[2 * (size_t)m] = mean; STAT[2 * (size_t)m + 1] = rstd; }
#pragma unroll
        for (int j = 0; j < 4; ++j) { const f32x4 y = v[j] * rstd * gv[j] + bv[j];
            o8[64 * j] = (unsigned long long)pk2(y.x, y.y) | ((unsigned long long)pk2(y.z, y.w) << 32); }
    }
}
__device__ __forceinline__ void mla_rows(const Frame& F, const Ptrs& P) {
    const int gw = F.vcu * NWAVES + F.wave, NGW = F.G * NWAVES, lane = F.lane;
    const float* C = (const float*)(P.ws + WS_MC); bf16* cqn = (bf16*)(P.ws + WS_CQN); bf16* ckvn = (bf16*)(P.ws + WS_CKVN); bf16* kr = (bf16*)(P.ws + WS_KROPE);
    float gq[6], gk[4];
#pragma unroll
    for (int j = 0; j < 6; ++j) gq[j] = P.mla_qn[lane + 64 * j];
#pragma unroll
    for (int j = 0; j < 4; ++j) gk[j] = P.mla_kvn[lane + 64 * j];
    const float fv = __builtin_amdgcn_exp2f(-(float)(lane & 31) * (13.287712379549449f / 32.0f)) * 0.15915494309189535f;
    for (int t = gw; t < T; t += NGW) {
        const float* c = C + (size_t)t * 768;
        float a[6], k[4]; float s = 0.f, s2 = 0.f;
#pragma unroll
        for (int j = 0; j < 6; ++j) { a[j] = c[lane + 64 * j]; s += a[j] * a[j]; }
#pragma unroll
        for (int j = 0; j < 4; ++j) { k[j] = c[384 + lane + 64 * j]; s2 += k[j] * k[j]; }
        const float v = c[640 + lane];
        const float rq = 1.f / sqrtf(wave_sum(s) * (1.f / 384.f) + LN_EPS), rk = 1.f / sqrtf(wave_sum(s2) * (1.f / 256.f) + LN_EPS);
#pragma unroll
        for (int j = 0; j < 6; ++j) cqn[(size_t)t * 384 + lane + 64 * j] = (bf16)f2bf(a[j] * rq * gq[j]);
#pragma unroll
        for (int j = 0; j < 4; ++j) ckvn[(size_t)t * 256 + lane + 64 * j] = (bf16)f2bf(k[j] * rk * gk[j]);
        const float pv = __shfl_xor(v, 32);
        float ang = (float)P.pos[t] * fv; ang = __builtin_amdgcn_fractf(ang);
        const float sn = __builtin_amdgcn_sinf(ang), cs = __builtin_amdgcn_cosf(ang);
        const float o = (lane < 32) ? (v * cs - pv * sn) : (pv * sn + v * cs);
        kr[(size_t)t * 64 + lane] = (bf16)f2bf(o);
    }
}

__device__ __forceinline__ const float* cv_src(const float* U, const float* V, int gp, int tid) { const int ch = (gp & 16383) >> 1;
    return ((ch < 4096) ? U + (size_t)ch * 4096 : V + (size_t)(ch - 4096) * 4096) + (size_t)(gp >> 14) * 16384 * 1024 + 2048 * (gp & 1) + 4 * tid; }
__device__ __forceinline__ unsigned char* cv_dst(unsigned char* U, int gp, int tid) { const int ch = (gp & 16383) >> 1;
    return U + (size_t)ch * 4096 + ((ch < 4096) ? (size_t)0 : (size_t)(WS_PV - WS_PU) - (size_t)4096 * 4096) + (size_t)(gp >> 14) * 16384 * 1024 + 2048 * (gp & 1) + 4 * tid; }
__device__ __forceinline__ void cv_store(unsigned char* d, const f32x4 v) { const float f0 = v[0], f1 = v[1], f2 = v[2], f3 = v[3];
    unsigned w = __builtin_amdgcn_cvt_pk_fp8_f32(f0 * 256.0f, f1 * 256.0f, 0, false); w = __builtin_amdgcn_cvt_pk_fp8_f32(f2 * 256.0f, f3 * 256.0f, w, true); *(GAS unsigned*)d = w; }

__device__ __forceinline__ void ret_unit(LAS unsigned char* lds, const bf16* __restrict__ Qg, const bf16* __restrict__ Kg, const bf16* __restrict__ Vg, bf16* Gz,
                                         const float* gng, const float* gnb, float lf, float lb, int b, int h, int qb,
                                         const float* cvU, const float* cvV, unsigned char* cdU, int cvu) {
    int tid = threadIdx.x; asm volatile("" : "+v"(tid));
    const int lane = tid & 63, wid = __builtin_amdgcn_readfirstlane(tid >> 6);
    const int qg = wid >> 1, vg = wid & 1, r32 = lane & 31, hh = lane >> 5;
    constexpr int QL = 0, KV0 = 65536, KVS = 49152, VOF = 16384, SCR = 65536;
    const size_t rowbase = (size_t)b * SEQ;
#pragma unroll
    for (int i = 0; i < 8; ++i) { const int c = tid + 512 * i, row = c >> 5, ch = c & 31;
        const v4u v = *(const GAS v4u*)(Qg + (rowbase + qb * 128 + row) * 1024 + h * 256 + ch * 8);
        *(LAS v4u*)(lds + QL + row * 512 + ((ch ^ (row & 15)) << 4)) = v; }
    const int kr0 = 2 * wid + (lane >> 5);
    const bf16* ksrc = Kg + (rowbase + kr0) * 1024 + h * 256 + (((lane & 31) ^ (kr0 & 15)) * 8);
    const bf16* vsrc = Vg + (rowbase + ((lane & 31) >> 2)) * 2048 + h * 512 + 32 * kr0 + 8 * (lane & 3);
#define RET_DMA_K(kt) do { _Pragma("unroll") for (int i = 0; i < 2; ++i) \
    __builtin_amdgcn_global_load_lds((const unsigned*)(ksrc + ((size_t)(kt) * 32 + 16 * i) * 1024), (LAS unsigned*)(lds + KV0 + ((kt) & 1) * KVS + (wid + 8 * i) * 1024), 16, 0, 0); } while (0)
#define RET_DMA_V(kt) do { _Pragma("unroll") for (int i = 0; i < 4; ++i) \
    __builtin_amdgcn_global_load_lds((const unsigned*)(vsrc + ((size_t)(kt) * 32 + 8 * i) * 2048), (LAS unsigned*)(lds + KV0 + ((kt) & 1) * KVS + VOF + (wid + 8 * i) * 1024), 16, 0, 0); } while (0)
    RET_DMA_K(0); RET_DMA_V(0); RET_DMA_K(1); RET_DMA_V(1);
    asm volatile("s_waitcnt vmcnt(6)" ::: "memory"); __syncthreads();
    f32x16 o[8];
#pragma unroll
    for (int d = 0; d < 8; ++d) o[d] = (f32x16){};
    const int nq = qb * 128 + qg * 32 + r32, sw = r32 & 7; (void)sw;
    const int q0w = qb * 128 + qg * 32;
    float fa[4], fb[4], ba[4], bb[4];
#pragma unroll
    for (int j = 0; j < 4; ++j) {
#define UNI(x) __builtin_bit_cast(float, __builtin_amdgcn_readfirstlane(__builtin_bit_cast(int, (float)(x))))
        fa[j] = UNI(__builtin_amdgcn_exp2f(-lf * (float)j)); fb[j] = UNI(__builtin_amdgcn_exp2f(-lf * (float)(8 * j))); ba[j] = UNI(__builtin_amdgcn_exp2f(lb * (float)j)); bb[j] = UNI(__builtin_amdgcn_exp2f(lb * (float)(8 * j)));
#undef UNI
    }
    const unsigned sw16 = (unsigned)(r32 & 15);
    const unsigned kbase = (unsigned)(unsigned long long)(lds + KV0 + r32 * 512), qbase = (unsigned)(unsigned long long)(lds + QL + (qg * 32 + r32) * 512);
#define KADR(si) (kbase + (((unsigned)(2 * (si) + hh) ^ sw16) << 4))
#define QADR(si) (qbase + (((unsigned)(2 * (si) + hh) ^ sw16) << 4))
    const unsigned vadr0 = (unsigned)(unsigned long long)(lds + KV0 + VOF + vg * 8 * 512 + (4 * hh + ((lane & 15) >> 2)) * 64 + (((lane >> 4) & 1) * 16 + 4 * (lane & 3)) * 2);
    const unsigned vadr1 = vadr0 + KVS;
#define DSR128(dst, adr, imm) asm volatile("ds_read_b128 %0, %1 offset:%2" : "=v"(dst) : "v"(adr), "i"(imm))
#define DSRTR(dst, adr, imm) asm volatile("ds_read_b64_tr_b16 %0, %1 offset:%2" : "=v"(dst) : "v"(adr), "i"(imm))
#define WAITL(n) do { asm volatile("s_waitcnt lgkmcnt(" #n ")" ::: "memory"); __builtin_amdgcn_sched_barrier(0); } while (0)
#ifndef RET_SREP
#define RET_SREP 1
#endif
#ifndef RET_TRDUP
#define RET_TRDUP 0
#endif
#ifndef RET_DECREP
#define RET_DECREP 1
#endif
#ifndef RET_PVREP
#define RET_PVREP 1
#endif
#ifndef RET_BARREP
#define RET_BARREP 1
#endif
#ifndef RET_DMADUP
#define RET_DMADUP 1
#endif
#define RET_DMA_K1(kt, i) __builtin_amdgcn_global_load_lds((const unsigned*)(ksrc + ((size_t)(kt) * 32 + 16 * (i)) * 1024), (LAS unsigned*)(lds + KV0 + ((kt) & 1) * KVS + (wid + 8 * (i)) * 1024), 16, 0, 0)
#define RET_DMA_V1(kt, i) __builtin_amdgcn_global_load_lds((const unsigned*)(vsrc + ((size_t)(kt) * 32 + 8 * (i)) * 2048), (LAS unsigned*)(lds + KV0 + ((kt) & 1) * KVS + VOF + (wid + 8 * (i)) * 1024), 16, 0, 0)
#define RET_STEP(ST, kt_) do { \
        f32x16 s = (f32x16){}; bf16x8 af[4], qf_[4]; \
        if ((kt_) > 0) cv_store(cv_dst(cdU, cvu * 64 + (kt_) - 1, tid), cvl); \
        cvl = *(const GAS f32x4*)cv_src(cvU, cvV, cvu * 64 + (kt_), tid);     \
        const bool dma_ = (kt_) >= 1 && (kt_) + 1 < SEQ / 32; \
        _Pragma("unroll") for (int j = 0; j < 4; ++j) { DSR128(af[j], KADR(j), (ST) * KVS); DSR128(qf_[j], QADR(j), 0); } \
        _Pragma("unroll") for (int si = 0; si < 16; ++si) { \
            if (si < 13) WAITL(6); else if (si == 13) WAITL(4); else if (si == 14) WAITL(2); else WAITL(0); \
            s = __builtin_amdgcn_mfma_f32_32x32x16_bf16(af[si & 3], qf_[si & 3], s, 0, 0, 0); \
            if (si + 4 < 16) { DSR128(af[si & 3], KADR(si + 4), (ST) * KVS); DSR128(qf_[si & 3], QADR(si + 4), 0); } \
            if (dma_) { if (si < 2) RET_DMA_K1((kt_) + 1, si); else if (si < 6) RET_DMA_V1((kt_) + 1, si - 2); } } \
        s16x4 vlo[4], vhi[4]; \
        _Pragma("unroll") for (int j = 0; j < 4; ++j) { DSRTR(vlo[j], ((ST) ? vadr1 : vadr0), ((2 * (j & 1)) * 16 + (j >> 1)) * 512); DSRTR(vhi[j], ((ST) ? vadr1 : vadr0), ((2 * (j & 1) + 1) * 16 + (j >> 1)) * 512); } \
        const float dbase = (float)(nq - (kt_) * 32 - 4 * hh); unsigned pw[8]; \
        if ((kt_) * 32 + 31 < q0w) {              \
            const float aL = __builtin_amdgcn_exp2f(lf * dbase); const float t0 = aL * fb[0], t1 = aL * fb[1], t2 = aL * fb[2], t3 = aL * fb[3]; \
            _Pragma("unroll") for (int r = 0; r < 16; r += 2) { const float tq = (r >> 2) == 0 ? t0 : (r >> 2) == 1 ? t1 : (r >> 2) == 2 ? t2 : t3; \
                pw[r >> 1] = pg8::cvt_pk_bf16(s[r] * (tq * fa[r & 3]), s[r + 1] * (tq * fa[(r + 1) & 3])); } \
        } else if ((kt_) * 32 > q0w + 31) {       \
            const float aL = __builtin_amdgcn_exp2f(-lb * dbase); const float t0 = aL * bb[0], t1 = aL * bb[1], t2 = aL * bb[2], t3 = aL * bb[3]; \
            _Pragma("unroll") for (int r = 0; r < 16; r += 2) { const float tq = (r >> 2) == 0 ? t0 : (r >> 2) == 1 ? t1 : (r >> 2) == 2 ? t2 : t3; \
                pw[r >> 1] = pg8::cvt_pk_bf16(s[r] * (tq * ba[r & 3]), s[r + 1] * (tq * ba[(r + 1) & 3])); } \
        } else { \
        _Pragma("unroll") for (int r = 0; r < 16; r += 2) { const float d0 = dbase - (float)crow0(r), d1 = dbase - (float)crow0(r + 1); \
            const float w0 = __builtin_amdgcn_exp2f(fminf(lf * d0, -lb * d0)), w1 = __builtin_amdgcn_exp2f(fminf(lf * d1, -lb * d1)); pw[r >> 1] = pg8::cvt_pk_bf16(s[r] * w0, s[r + 1] * w1); } } \
        const bf16x8 pa0 = __builtin_bit_cast(bf16x8, (v4u){pw[0], pw[1], pw[2], pw[3]}), pa1 = __builtin_bit_cast(bf16x8, (v4u){pw[4], pw[5], pw[6], pw[7]}); \
        _Pragma("unroll") for (int j = 0; j < 16; ++j) { \
            if (j < 13) WAITL(6); else if (j == 13) WAITL(4); else if (j == 14) WAITL(2); else WAITL(0); \
            const s16x4 lo_ = vlo[j & 3], hi_ = vhi[j & 3]; const bf16x8 vb_ = (bf16x8){lo_[0], lo_[1], lo_[2], lo_[3], hi_[0], hi_[1], hi_[2], hi_[3]}; \
            o[j >> 1] = __builtin_amdgcn_mfma_f32_32x32x16_bf16((j & 1) ? pa1 : pa0, vb_, o[j >> 1], 0, 0, 0); \
            if (j + 4 < 16) { DSRTR(vlo[j & 3], ((ST) ? vadr1 : vadr0), ((2 * ((j + 4) & 1)) * 16 + ((j + 4) >> 1)) * 512); DSRTR(vhi[j & 3], ((ST) ? vadr1 : vadr0), ((2 * ((j + 4) & 1) + 1) * 16 + ((j + 4) >> 1)) * 512); } } \
        VM_WAIT(); __syncthreads(); } while (0)
    f32x4 cvl = (f32x4){0.f, 0.f, 0.f, 0.f};
#pragma unroll 1
    for (int kt = 0; kt < SEQ / 32; kt += 2) { RET_STEP(0, kt); RET_STEP(1, kt + 1); }
    cv_store(cv_dst(cdU, cvu * 64 + SEQ / 32 - 1, tid), cvl);
#undef RET_STEP
#undef DSR128
#undef KADR
#undef QADR
#undef DSRTR
#undef WAITL
#undef RET_DMA_K
#undef RET_DMA_K1
#undef RET_DMA_V1
#undef RET_DMA_V
    constexpr int SCR2 = 131072;
    { const bf16* gsrc = Gz + (rowbase + qb * 128 + 16 * wid) * 2048 + h * 512 + 8 * lane;
#pragma unroll 1
      for (int i = 0; i < 16; ++i) __builtin_amdgcn_global_load_lds((const unsigned*)(gsrc + (size_t)i * 2048), (LAS unsigned*)(lds + (16 * wid + i) * 1024), 16, 0, 0); }
    float sm[16], sq[16];
#pragma unroll
    for (int r = 0; r < 16; ++r) { float a = 0.f, q = 0.f;
#pragma unroll
        for (int dt = 0; dt < 8; ++dt) { const float v = o[dt][r]; a += v; q += v * v; }
#pragma unroll
        for (int of = 1; of < 32; of <<= 1) { a += __shfl_xor(a, of); q += __shfl_xor(q, of); }
        sm[r] = a; sq[r] = q; if ((r & 1) == 1) __builtin_amdgcn_sched_barrier(0); }
    LAS float* scr = (LAS float*)(lds + SCR2);
    if (r32 == 0) {
#pragma unroll
        for (int r = 0; r < 16; ++r) { const int row = crow0(r) + 4 * hh; scr[((qg * 2 + vg) * 32 + row) * 2] = sm[r]; scr[((qg * 2 + vg) * 32 + row) * 2 + 1] = sq[r]; } }
    VM_WAIT(); __syncthreads();
    float gg[8], gb[8];
#pragma unroll
    for (int dt = 0; dt < 8; ++dt) { const int col = h * 512 + vg * 256 + dt * 32 + r32; gg[dt] = gng[col]; gb[dt] = gnb[col]; }
#pragma unroll
    for (int r = 0; r < 16; ++r) {
        const int row = crow0(r) + 4 * hh;
        const float a = scr[((qg * 2) * 32 + row) * 2] + scr[((qg * 2 + 1) * 32 + row) * 2], q = scr[((qg * 2) * 32 + row) * 2 + 1] + scr[((qg * 2 + 1) * 32 + row) * 2 + 1];
        const float mean = a * (1.f / 512.f), var = q * (1.f / 512.f) - mean * mean, rstd = __builtin_amdgcn_rsqf(var + LN_EPS);
        LAS bf16* lp = (LAS bf16*)(lds + (qg * 32 + row) * 1024) + vg * 256 + r32;
#pragma unroll
        for (int dt = 0; dt < 8; ++dt) {
            const float yn = (o[dt][r] - mean) * rstd * gg[dt] + gb[dt];
            const float g = bf2f(lp[dt * 32]);
            const float z = g * __builtin_amdgcn_rcpf(1.f + __expf(-g)) * yn;
            lp[dt * 32] = (bf16)f2bf(z);
        }
    }
    __syncthreads();
    { bf16* zdst = Gz + (rowbase + qb * 128 + 16 * wid) * 2048 + h * 512 + 8 * lane;
#pragma unroll 4
      for (int i = 0; i < 16; ++i) { const v4u v = *(LAS v4u*)(lds + (16 * wid + i) * 1024 + 16 * lane); *(GAS v4u*)(zdst + (size_t)i * 2048) = v; } }
    __syncthreads();
}

__device__ __forceinline__ void ret_unit16(LAS unsigned char* lds, const bf16* __restrict__ Qg, const bf16* __restrict__ Kg, const bf16* __restrict__ Vg, bf16* Gz,
                                           const float* gng, const float* gnb, float lf, float lb, int b, int h, int qb,
                                           const float* cvU, const float* cvV, unsigned char* cdU, int cvu) {
    int tid = threadIdx.x; asm volatile("" : "+v"(tid));
    const int lane = tid & 63, wid = __builtin_amdgcn_readfirstlane(tid >> 6);
    const int n16 = lane & 15, g4 = lane >> 4;
    constexpr int KV0 = 0, KVS = 49152, VOF = 16384;
    const size_t rowbase = (size_t)b * SEQ;
    const int q0w = qb * 128 + 16 * wid;
    bf16x8 qf[8];
    { const bf16* qr = Qg + (rowbase + q0w + n16) * 1024 + h * 256 + 8 * g4;
#pragma unroll
      for (int s = 0; s < 8; ++s) qf[s] = *(const GAS bf16x8*)(qr + 32 * s); }
    const int kr0 = 2 * wid + (lane >> 5);
    const bf16* ksrc = Kg + (rowbase + kr0) * 1024 + h * 256 + (((lane & 31) ^ (kr0 & 15)) * 8);
    const int vr0 = 4 * wid + (lane >> 4), vx0 = ((vr0 & 3) << 2) | ((vr0 >> 2) & 3);
    const bf16* vsrc = Vg + (rowbase + vr0) * 2048 + h * 512 + 8 * ((lane & 15) ^ vx0);
#define R16_DMA_K1(kt, i) __builtin_amdgcn_global_load_lds((const unsigned*)(ksrc + ((size_t)(kt) * 32 + 16 * (i)) * 1024), (LAS unsigned*)(lds + KV0 + ((kt) & 1) * KVS + (wid + 8 * (i)) * 1024), 16, 0, 0)
#define R16_DMA_V1(kt, i) __builtin_amdgcn_global_load_lds((const unsigned*)(vsrc + (size_t)(kt) * 32 * 2048 + 128 * (i)), (LAS unsigned*)(lds + KV0 + ((kt) & 1) * KVS + VOF + 8192 * (i) + wid * 1024), 16, 0, 0)
#pragma unroll
    for (int t0 = 0; t0 < 2; ++t0) { R16_DMA_K1(t0, 0); R16_DMA_K1(t0, 1); R16_DMA_V1(t0, 0); R16_DMA_V1(t0, 1); R16_DMA_V1(t0, 2); R16_DMA_V1(t0, 3); }
    asm volatile("s_waitcnt vmcnt(6)" ::: "memory"); __syncthreads();
    f32x4 o[32];
#pragma unroll
    for (int d = 0; d < 32; ++d) o[d] = (f32x4){0.f, 0.f, 0.f, 0.f};
    float FA[8], BA[8];
#pragma unroll
    for (int j = 0; j < 8; ++j) {
#define UNI(x) __builtin_bit_cast(float, __builtin_amdgcn_readfirstlane(__builtin_bit_cast(int, (float)(x))))
        const float e_ = (float)(16 * (j >> 2) + (j & 3));
        FA[j] = UNI(__builtin_amdgcn_exp2f(-lf * e_)); BA[j] = UNI(__builtin_amdgcn_exp2f(lb * e_));
#undef UNI
    }
    const int kg0 = 8 * (g4 & 1) + 4 * (g4 >> 1);
    const int pi_ = 8 * ((n16 >> 2) & 1) + 4 * (n16 >> 3) + (n16 & 3);
    unsigned kb[4];
#pragma unroll
    for (int bb = 0; bb < 4; ++bb) kb[bb] = (unsigned)(unsigned long long)(lds + KV0) + 512u * pi_ + 64u * (unsigned)(bb ^ (pi_ >> 2)) + 16u * (unsigned)(g4 ^ (pi_ & 3));
    unsigned vbc[8];
    { const int qq = n16 >> 2, pp = n16 & 3, xx = (qq << 2) | ((kg0 >> 2) & 3);
#pragma unroll
      for (int c = 0; c < 8; ++c) { vbc[c] = (unsigned)(unsigned long long)(lds + KV0 + VOF) + 256u * (unsigned)(kg0 + qq) + 16u * (unsigned)((2 * c + (pp >> 1)) ^ xx) + 8u * (unsigned)(pp & 1); } }
#define DSR128(dst, adr, imm) asm volatile("ds_read_b128 %0, %1 offset:%2" : "=v"(dst) : "v"(adr), "i"(imm))
#define DSRTR(dst, adr, imm) asm volatile("ds_read_b64_tr_b16 %0, %1 offset:%2" : "=v"(dst) : "v"(adr), "i"(imm))
#define WAITL(n) do { asm volatile("s_waitcnt lgkmcnt(" #n ")" ::: "memory"); __builtin_amdgcn_sched_barrier(0); } while (0)
#define R16_VB(ST, c) (vbc[c])
    f32x4 cvl = (f32x4){0.f, 0.f, 0.f, 0.f};
#define R16_STEP(ST, kt_) do { \
        if ((kt_) > 0) cv_store(cv_dst(cdU, cvu * 64 + (kt_) - 1, tid), cvl); \
        cvl = *(const GAS f32x4*)cv_src(cvU, cvV, cvu * 64 + (kt_), tid); \
        const bool dma_ = (kt_) >= 1 && (kt_) + 1 < SEQ / 32; \
        f32x4 s0 = (f32x4){0.f, 0.f, 0.f, 0.f}, s1 = s0; bf16x8 k0r[4], k1r[4]; \
        _Pragma("unroll") for (int j = 0; j < 4; ++j) { DSR128(k0r[j], kb[j & 3], (ST) * KVS + 256 * (j >> 2)); DSR128(k1r[j], kb[j & 3], (ST) * KVS + 8192 + 256 * (j >> 2)); } \
        _Pragma("unroll") for (int si = 0; si < 8; ++si) { \
            if (si < 5) WAITL(6); else if (si == 5) WAITL(4); else if (si == 6) WAITL(2); else WAITL(0); \
            s0 = __builtin_amdgcn_mfma_f32_16x16x32_bf16(k0r[si & 3], qf[si], s0, 0, 0, 0); \
            s1 = __builtin_amdgcn_mfma_f32_16x16x32_bf16(k1r[si & 3], qf[si], s1, 0, 0, 0); \
            if (si + 4 < 8) { DSR128(k0r[si & 3], kb[(si + 4) & 3], (ST) * KVS + 256 * ((si + 4) >> 2)); DSR128(k1r[si & 3], kb[(si + 4) & 3], (ST) * KVS + 8192 + 256 * ((si + 4) >> 2)); } \
            if (dma_ && si < 6) { if (si < 2) R16_DMA_K1((kt_) + 1, si); else R16_DMA_V1((kt_) + 1, si - 2); } } \
        s16x4 vlo[4], vhi[4]; \
        _Pragma("unroll") for (int j = 0; j < 4; ++j) { DSRTR(vlo[j], R16_VB(ST, j & 7), 8192 * (j >> 3)); DSRTR(vhi[j], R16_VB(ST, j & 7), 8192 * (j >> 3) + 4096); } \
        const float dbase = (float)(q0w + n16 - (kt_) * 32 - kg0); float p0[4], p1[4]; \
        if ((kt_) * 32 + 31 < q0w) { \
            const float aL = __builtin_amdgcn_exp2f(lf * dbase); \
            _Pragma("unroll") for (int r = 0; r < 4; ++r) { p0[r] = s0[r] * (aL * FA[r]); p1[r] = s1[r] * (aL * FA[4 + r]); } \
        } else if ((kt_) * 32 > q0w + 15) { \
            const float aL = __builtin_amdgcn_exp2f(-lb * dbase); \
            _Pragma("unroll") for (int r = 0; r < 4; ++r) { p0[r] = s0[r] * (aL * BA[r]); p1[r] = s1[r] * (aL * BA[4 + r]); } \
        } else { \
            _Pragma("unroll") for (int r = 0; r < 4; ++r) { const float d0 = dbase - (float)r, d1 = dbase - (float)(16 + r); \
                p0[r] = s0[r] * __builtin_amdgcn_exp2f(fminf(lf * d0, -lb * d0)); p1[r] = s1[r] * __builtin_amdgcn_exp2f(fminf(lf * d1, -lb * d1)); } } \
        const bf16x8 pa = __builtin_bit_cast(bf16x8, (v4u){pg8::cvt_pk_bf16(p0[0], p0[1]), pg8::cvt_pk_bf16(p0[2], p0[3]), pg8::cvt_pk_bf16(p1[0], p1[1]), pg8::cvt_pk_bf16(p1[2], p1[3])}); \
        _Pragma("unroll") for (int ct = 0; ct < 32; ++ct) { \
            if (ct < 29) WAITL(6); else if (ct == 29) WAITL(4); else if (ct == 30) WAITL(2); else WAITL(0); \
            const s16x4 lo_ = vlo[ct & 3], hi_ = vhi[ct & 3]; const bf16x8 vb_ = (bf16x8){lo_[0], lo_[1], lo_[2], lo_[3], hi_[0], hi_[1], hi_[2], hi_[3]}; \
            o[ct] = __builtin_amdgcn_mfma_f32_16x16x32_bf16(pa, vb_, o[ct], 0, 0, 0); \
            if (ct + 4 < 32) { DSRTR(vlo[ct & 3], R16_VB(ST, (ct + 4) & 7), 8192 * ((ct + 4) >> 3)); DSRTR(vhi[ct & 3], R16_VB(ST, (ct + 4) & 7), 8192 * ((ct + 4) >> 3) + 4096); } \
            } \
        _Pragma("unroll") for (int c = 0; c < 8; ++c) vbc[c] += (ST) ? (unsigned)(-KVS) : (unsigned)KVS; \
        VM_WAIT(); __syncthreads(); } while (0)
#pragma unroll 1
    for (int kt = 0; kt < SEQ / 32; kt += 2) { R16_STEP(0, kt); R16_STEP(1, kt + 1); }
    cv_store(cv_dst(cdU, cvu * 64 + SEQ / 32 - 1, tid), cvl);
#undef R16_STEP
#undef R16_VB
#undef DSR128
#undef DSRTR
#undef WAITL
#undef R16_DMA_K1
#undef R16_DMA_V1
    { const bf16* gsrc = Gz + (rowbase + qb * 128 + 16 * wid) * 2048 + h * 512 + 8 * lane;
#pragma unroll 1
      for (int i = 0; i < 16; ++i) __builtin_amdgcn_global_load_lds((const unsigned*)(gsrc + (size_t)i * 2048), (LAS unsigned*)(lds + (16 * wid + i) * 1024), 16, 0, 0); }
    float mean[4], rstd[4];
#pragma unroll
    for (int r = 0; r < 4; ++r) { float a = 0.f, q = 0.f;
#pragma unroll
        for (int ct = 0; ct < 32; ++ct) { const float v = o[ct][r]; a += v; q += v * v; }
#define R16_ROR(x, c) x += __builtin_bit_cast(float, __builtin_amdgcn_update_dpp(0, __builtin_bit_cast(int, x), c, 0xf, 0xf, false))
        R16_ROR(a, 0x128); R16_ROR(q, 0x128); R16_ROR(a, 0x124); R16_ROR(q, 0x124); R16_ROR(a, 0x122); R16_ROR(q, 0x122); R16_ROR(a, 0x121); R16_ROR(q, 0x121);
#undef R16_ROR
        mean[r] = a * (1.f / 512.f); rstd[r] = __builtin_amdgcn_rsqf(q * (1.f / 512.f) - mean[r] * mean[r] + LN_EPS); }
    VM_WAIT(); __syncthreads();
#pragma unroll
    for (int ct = 0; ct < 32; ++ct) {
        const int col = h * 512 + 16 * ct + n16; const float gg = gng[col], gb = gnb[col];
#pragma unroll
        for (int r = 0; r < 4; ++r) {
            LAS bf16* lp = (LAS bf16*)(lds + (16 * wid + 4 * g4 + r) * 1024) + 16 * ct + n16;
            const float yn = (o[ct][r] - mean[r]) * rstd[r] * gg + gb;
            const float g = bf2f(*lp);
            *lp = (bf16)f2bf(g * __builtin_amdgcn_rcpf(1.f + __expf(-g)) * yn);
        }
    }
    __syncthreads();
    { bf16* zdst = Gz + (rowbase + qb * 128 + 16 * wid) * 2048 + h * 512 + 8 * lane;
#pragma unroll 4
      for (int i = 0; i < 16; ++i) { const v4u v = *(LAS v4u*)(lds + (16 * wid + i) * 1024 + 16 * lane); *(GAS v4u*)(zdst + (size_t)i * 2048) = v; } }
    __syncthreads();
}

__device__ __forceinline__ void ret_unitpx(LAS unsigned char* lds, const bf16* __restrict__ Qg, const bf16* __restrict__ Kg, const bf16* __restrict__ Vg, bf16* Gz,
                                           const float* gng, const float* gnb, float lf, float lb, int b, int h, int qb,
                                           const float* cvU, const float* cvV, unsigned char* cdU, int cvu) {
    int tid = threadIdx.x; asm volatile("" : "+v"(tid));
    const int lane = tid & 63, wid = __builtin_amdgcn_readfirstlane(tid >> 6);
    const int n16 = lane & 15, g4 = lane >> 4;
    constexpr int KVS = 49152, VOF = 16384, PB = 147456, SCR = 131072;
    const size_t rowbase = (size_t)b * SEQ;
    const int q0w = qb * 128 + 16 * wid;
    bf16x8 qf[8];
    { const bf16* qr = Qg + (rowbase + q0w + n16) * 1024 + h * 256 + 8 * g4;
#pragma unroll
      for (int s = 0; s < 8; ++s) qf[s] = *(const GAS bf16x8*)(qr + 32 * s); }
    const int kr0 = 2 * wid + (lane >> 5);
    const bf16* ksrc = Kg + (rowbase + kr0) * 1024 + h * 256 + (((lane & 31) ^ (kr0 & 15)) * 8);
    const int vr0 = 4 * wid + (lane >> 4), vx0 = ((vr0 & 3) << 2) | ((vr0 >> 2) & 3);
    const bf16* vsrc = Vg + (rowbase + vr0) * 2048 + h * 512 + 8 * ((lane & 15) ^ vx0);
#define RPX_DMA_K(kt, stg) do { \
    _Pragma("unroll") for (int i = 0; i < 2; ++i) __builtin_amdgcn_global_load_lds((const unsigned*)(ksrc + ((size_t)(kt) * 32 + 16 * i) * 1024), (LAS unsigned*)(lds + (stg) * KVS + (wid + 8 * i) * 1024), 16, 0, 0); } while (0)
#define RPX_DMA_V(kt, stg) do { \
    _Pragma("unroll") for (int i = 0; i < 4; ++i) __builtin_amdgcn_global_load_lds((const unsigned*)(vsrc + (size_t)(kt) * 32 * 2048 + 128 * i), (LAS unsigned*)(lds + (stg) * KVS + VOF + 8192 * i + wid * 1024), 16, 0, 0); } while (0)
    RPX_DMA_K(0, 0); RPX_DMA_K(1, 1); RPX_DMA_K(2, 2); RPX_DMA_V(0, 0); RPX_DMA_V(1, 1);
    asm volatile("s_waitcnt vmcnt(12)" ::: "memory"); __syncthreads();
    f32x4 o[8][4];
#pragma unroll
    for (int t = 0; t < 8; ++t)
#pragma unroll
        for (int c = 0; c < 4; ++c) o[t][c] = (f32x4){0.f, 0.f, 0.f, 0.f};
    float FA[8], BA[8];
#pragma unroll
    for (int j = 0; j < 8; ++j) {
#define UNI(x) __builtin_bit_cast(float, __builtin_amdgcn_readfirstlane(__builtin_bit_cast(int, (float)(x))))
        const float e_ = (float)(16 * (j >> 2) + (j & 3));
        FA[j] = UNI(__builtin_amdgcn_exp2f(-lf * e_)); BA[j] = UNI(__builtin_amdgcn_exp2f(lb * e_));
#undef UNI
    }
    const int kg0 = 8 * (g4 & 1) + 4 * (g4 >> 1);
    const int pi_ = 8 * ((n16 >> 2) & 1) + 4 * (n16 >> 3) + (n16 & 3);
    unsigned kb[4];
#pragma unroll
    for (int bb = 0; bb < 4; ++bb) kb[bb] = (unsigned)(unsigned long long)lds + 512u * pi_ + 64u * (unsigned)(bb ^ (pi_ >> 2)) + 16u * (unsigned)(g4 ^ (pi_ & 3));
    unsigned vb4[4];
    { const int qq = n16 >> 2, pp = n16 & 3, xx = (qq << 2) | ((kg0 >> 2) & 3);
#pragma unroll
      for (int c = 0; c < 4; ++c) vb4[c] = (unsigned)(unsigned long long)(lds + VOF) + 8192u * (unsigned)(wid >> 1) + 256u * (unsigned)(kg0 + qq) + 16u * (unsigned)((2 * (4 * (wid & 1) + c) + (pp >> 1)) ^ xx) + 8u * (unsigned)(pp & 1); }
    unsigned pwr = (unsigned)(unsigned long long)(lds + PB) + 1024u * (unsigned)wid + 16u * (unsigned)lane, prd = (unsigned)(unsigned long long)(lds + PB) + 16u * (unsigned)lane;
#define DSR128(dst, adr, imm) asm volatile("ds_read_b128 %0, %1 offset:%2" : "=v"(dst) : "v"(adr), "i"(imm))
#define DSRTR(dst, adr, imm) asm volatile("ds_read_b64_tr_b16 %0, %1 offset:%2" : "=v"(dst) : "v"(adr), "i"(imm))
#define WAITL(n) do { asm volatile("s_waitcnt lgkmcnt(" #n ")" ::: "memory"); __builtin_amdgcn_sched_barrier(0); } while (0)
    f32x4 cvl = (f32x4){0.f, 0.f, 0.f, 0.f};
#define RPX_S(ktn) do { \
        f32x4 s0 = (f32x4){0.f, 0.f, 0.f, 0.f}, s1 = s0; bf16x8 k0r[4], k1r[4]; \
        _Pragma("unroll") for (int j = 0; j < 4; ++j) { DSR128(k0r[j], kb[j & 3], 256 * (j >> 2)); DSR128(k1r[j], kb[j & 3], 8192 + 256 * (j >> 2)); } \
        _Pragma("unroll") for (int si = 0; si < 8; ++si) { \
            if (si < 5) WAITL(6); else if (si == 5) WAITL(4); else if (si == 6) WAITL(2); else WAITL(0); \
            s0 = __builtin_amdgcn_mfma_f32_16x16x32_bf16(k0r[si & 3], qf[si], s0, 0, 0, 0); \
            s1 = __builtin_amdgcn_mfma_f32_16x16x32_bf16(k1r[si & 3], qf[si], s1, 0, 0, 0); \
            if (si + 4 < 8) { DSR128(k0r[si & 3], kb[(si + 4) & 3], 256 * ((si + 4) >> 2)); DSR128(k1r[si & 3], kb[(si + 4) & 3], 8192 + 256 * ((si + 4) >> 2)); } } \
        const float dbase = (float)(q0w + n16 - (ktn) * 32 - kg0); float p0[4], p1[4]; \
        if ((ktn) * 32 + 31 < q0w) { \
            const float aL = __builtin_amdgcn_exp2f(lf * dbase); \
            _Pragma("unroll") for (int r = 0; r < 4; ++r) { p0[r] = s0[r] * (aL * FA[r]); p1[r] = s1[r] * (aL * FA[4 + r]); } \
        } else if ((ktn) * 32 > q0w + 15) { \
            const float aL = __builtin_amdgcn_exp2f(-lb * dbase); \
            _Pragma("unroll") for (int r = 0; r < 4; ++r) { p0[r] = s0[r] * (aL * BA[r]); p1[r] = s1[r] * (aL * BA[4 + r]); } \
        } else { \
            _Pragma("unroll") for (int r = 0; r < 4; ++r) { const float d0 = dbase - (float)r, d1 = dbase - (float)(16 + r); \
                p0[r] = s0[r] * __builtin_amdgcn_exp2f(fminf(lf * d0, -lb * d0)); p1[r] = s1[r] * __builtin_amdgcn_exp2f(fminf(lf * d1, -lb * d1)); } } \
        { const v4u pw = (v4u){pg8::cvt_pk_bf16(p0[0], p0[1]), pg8::cvt_pk_bf16(p0[2], p0[3]), pg8::cvt_pk_bf16(p1[0], p1[1]), pg8::cvt_pk_bf16(p1[2], p1[3])}; \
          asm volatile("ds_write_b128 %0, %1" :: "v"(pwr), "v"(pw) : "memory"); } } while (0)
#define RPX_PV() do { \
        bf16x8 vfr[4]; s16x4 vlo[4], vhi[4]; bf16x8 par[4]; \
        _Pragma("unroll") for (int c = 0; c < 4; ++c) { DSRTR(vlo[c], vb4[c], 0); DSRTR(vhi[c], vb4[c], 4096); } \
        _Pragma("unroll") for (int j = 0; j < 4; ++j) DSR128(par[j], prd, 1024 * j); \
        WAITL(4); \
        _Pragma("unroll") for (int c = 0; c < 4; ++c) { const s16x4 lo_ = vlo[c], hi_ = vhi[c]; vfr[c] = (bf16x8){lo_[0], lo_[1], lo_[2], lo_[3], hi_[0], hi_[1], hi_[2], hi_[3]}; } \
        _Pragma("unroll") for (int t = 0; t < 8; ++t) { \
            if (t < 5) WAITL(3); else if (t == 5) WAITL(2); else if (t == 6) WAITL(1); else WAITL(0); \
            _Pragma("unroll") for (int c = 0; c < 4; ++c) o[t][c] = __builtin_amdgcn_mfma_f32_16x16x32_bf16(par[t & 3], vfr[c], o[t][c], 0, 0, 0); \
            if (t + 4 < 8) DSR128(par[t & 3], prd, 1024 * (t + 4)); } } while (0)
    RPX_S(0);
    asm volatile("s_waitcnt vmcnt(4) lgkmcnt(0)" ::: "memory"); __syncthreads();
#pragma unroll
    for (int j = 0; j < 4; ++j) kb[j] += KVS;
    pwr += 8192u;
    int stg = 0;
#pragma unroll 1
    for (int kt = 0; kt < SEQ / 32; ++kt) {
        if (kt > 0) cv_store(cv_dst(cdU, cvu * 64 + kt - 1, tid), cvl);
        cvl = *(const GAS f32x4*)cv_src(cvU, cvV, cvu * 64 + kt, tid);
        if (kt + 3 < SEQ / 32) RPX_DMA_K(kt + 3, stg);
        if (kt + 2 < SEQ / 32) { const int s2 = (stg == 0) ? 2 : stg - 1; RPX_DMA_V(kt + 2, s2); }
        if (wid < 4 && kt + 1 < SEQ / 32) RPX_S(kt + 1);
        RPX_PV();
        if (wid >= 4 && kt + 1 < SEQ / 32) RPX_S(kt + 1);
        { const unsigned dv_ = (stg == 2) ? (unsigned)(-2 * KVS) : (unsigned)KVS, dk_ = (stg == 1) ? (unsigned)(-2 * KVS) : (unsigned)KVS;
#pragma unroll
          for (int j = 0; j < 4; ++j) { kb[j] += dk_; vb4[j] += dv_; }
          const unsigned dp_ = (kt & 1) ? (unsigned)(-8192) : 8192u; prd += dp_; pwr -= dp_;
          stg = (stg == 2) ? 0 : stg + 1; }
        if (kt + 3 < SEQ / 32) asm volatile("s_waitcnt vmcnt(7) lgkmcnt(0)" ::: "memory");
        else asm volatile("s_waitcnt vmcnt(0) lgkmcnt(0)" ::: "memory");
        __syncthreads();
    }
#undef RPX_S
#undef RPX_PV
    cv_store(cv_dst(cdU, cvu * 64 + SEQ / 32 - 1, tid), cvl);
#undef DSR128
#undef DSRTR
#undef WAITL
#undef RPX_DMA_K
#undef RPX_DMA_V
    __syncthreads();
    { const bf16* gsrc = Gz + (rowbase + qb * 128 + 16 * wid) * 2048 + h * 512 + 8 * lane;
#pragma unroll 1
      for (int i = 0; i < 16; ++i) __builtin_amdgcn_global_load_lds((const unsigned*)(gsrc + (size_t)i * 2048), (LAS unsigned*)(lds + (16 * wid + i) * 1024), 16, 0, 0); }
    LAS float* scr = (LAS float*)(lds + SCR);
#pragma unroll
    for (int t = 0; t < 8; ++t)
#pragma unroll
        for (int r = 0; r < 4; ++r) { float a = 0.f, q = 0.f;
#pragma unroll
            for (int c = 0; c < 4; ++c) { const float v = o[t][c][r]; a += v; q += v * v; }
#define RPX_ROR(x, cc) x += __builtin_bit_cast(float, __builtin_amdgcn_update_dpp(0, __builtin_bit_cast(int, x), cc, 0xf, 0xf, false))
            RPX_ROR(a, 0x128); RPX_ROR(q, 0x128); RPX_ROR(a, 0x124); RPX_ROR(q, 0x124); RPX_ROR(a, 0x122); RPX_ROR(q, 0x122); RPX_ROR(a, 0x121); RPX_ROR(q, 0x121);
#undef RPX_ROR
            if (n16 == 0) { scr[(wid * 128 + 16 * t + 4 * g4 + r) * 2] = a; scr[(wid * 128 + 16 * t + 4 * g4 + r) * 2 + 1] = q; } }
    __syncthreads();
    if (tid < 128) { float a = 0.f, q = 0.f;
#pragma unroll
        for (int w = 0; w < 8; ++w) { a += scr[(w * 128 + tid) * 2]; q += scr[(w * 128 + tid) * 2 + 1]; }
        const float mean = a * (1.f / 512.f); scr[2048 + 2 * tid] = mean; scr[2048 + 2 * tid + 1] = __builtin_amdgcn_rsqf(q * (1.f / 512.f) - mean * mean + LN_EPS); }
    VM_WAIT(); __syncthreads();
    float gg[4], gb[4];
#pragma unroll
    for (int c = 0; c < 4; ++c) { const int col = h * 512 + 64 * wid + 16 * c + n16; gg[c] = gng[col]; gb[c] = gnb[col]; }
#pragma unroll
    for (int t = 0; t < 8; ++t)
#pragma unroll
        for (int r = 0; r < 4; ++r) { const int row = 16 * t + 4 * g4 + r; const float mean = scr[2048 + 2 * row], rstd = scr[2048 + 2 * row + 1];
#pragma unroll
            for (int c = 0; c < 4; ++c) {
                LAS bf16* lp = (LAS bf16*)(lds + row * 1024) + 64 * wid + 16 * c + n16;
                const float yn = (o[t][c][r] - mean) * rstd * gg[c] + gb[c];
                const float g = bf2f(*lp);
                *lp = (bf16)f2bf(g * __builtin_amdgcn_rcpf(1.f + __expf(-g)) * yn); } }
    __syncthreads();
    { bf16* zdst = Gz + (rowbase + qb * 128 + 16 * wid) * 2048 + h * 512 + 8 * lane;
#pragma unroll 4
      for (int i = 0; i < 16; ++i) { const v4u v = *(LAS v4u*)(lds + (16 * wid + i) * 1024 + 16 * lane); *(GAS v4u*)(zdst + (size_t)i * 2048) = v; } }
    __syncthreads();
}

__device__ __forceinline__ void mla_unit(LAS unsigned char* lds, const bf16* __restrict__ Qg, const bf16* __restrict__ KVg, const bf16* __restrict__ KRg, bf16* Og, int b, int h, int qb) {
    int tid = threadIdx.x; asm volatile("" : "+v"(tid));
    const int lane = tid & 63, wid = __builtin_amdgcn_readfirstlane(tid >> 6);
    const int r32 = lane & 31, hh = lane >> 5;
    constexpr int STG = 40960, KOFF = 0, VOFF = 24576, SCR = 122880;
    const size_t rowbase = (size_t)b * SEQ;
    bf16x8 qf[12];
    { const bf16* qr = Qg + (rowbase + qb * 256 + wid * 32 + r32) * 1536;
#pragma unroll
      for (int s = 0; s < 8; ++s) qf[s] = *(const GAS bf16x8*)(qr + h * 128 + 16 * s + 8 * hh);
#pragma unroll
      for (int s = 0; s < 2; ++s) { qf[8 + s] = *(const GAS bf16x8*)(qr + 1024 + 256 * (h >> 2) + (h & 3) * 32 + 16 * s + 8 * hh);
                                    qf[10 + s] = *(const GAS bf16x8*)(qr + 1024 + 256 * (h >> 2) + 128 + (h & 3) * 32 + 16 * s + 8 * hh); } }
    const bf16* ksrc[3]; int kstr[3];
#pragma unroll
    for (int i = 0; i < 3; ++i) { const int off = 1024 * (wid + 8 * i) + 16 * lane, row = off / 384, pos = (off % 384) >> 4, ch = pos ^ (row & 7);
        if (ch < 16) { ksrc[i] = KVg + (rowbase + row) * 2048 + h * 256 + ch * 8; kstr[i] = 64 * 2048; }
        else         { ksrc[i] = KRg + (rowbase + row) * 64 + (ch - 16) * 8;       kstr[i] = 64 * 64; } }
    const int vs0 = 2 * wid + (lane >> 5);
    const bf16* vsrc = KVg + (rowbase + 8 * (vs0 >> 2) + ((lane & 31) >> 2)) * 2048 + h * 256 + 128 + 32 * (vs0 & 3) + 8 * (lane & 3);
#define MLA_DMA(kt, buf) do { \
    _Pragma("unroll") for (int i = 0; i < 3; ++i) __builtin_amdgcn_global_load_lds((const unsigned*)(ksrc[i] + (size_t)(kt) * kstr[i]), (LAS unsigned*)(lds + (buf) * STG + KOFF + (wid + 8 * i) * 1024), 16, 0, 0); \
    _Pragma("unroll") for (int i = 0; i < 2; ++i) __builtin_amdgcn_global_load_lds((const unsigned*)(vsrc + ((size_t)(kt) * 64 + 32 * i) * 2048), (LAS unsigned*)(lds + (buf) * STG + VOFF + (wid + 8 * i) * 1024), 16, 0, 0); } while (0)
    MLA_DMA(0, 0); MLA_DMA(1, 1);
    int st = 0;
    f32x16 o[4];
#pragma unroll
    for (int d = 0; d < 4; ++d) o[d] = (f32x16){};
    float mref = -INFINITY, lsum = 0.f;
    const int sw = r32 & 7;
    LAS float* scr = (LAS float*)(lds + SCR) + wid * 64;
    const int vlane = VOFF + (4 * hh + ((lane & 15) >> 2)) * 64 + (((lane >> 4) & 1) * 16 + 4 * (lane & 3)) * 2;
    for (int kt = 0; kt < SEQ / 64; ++kt) {
        if (kt + 1 < SEQ / 64) asm volatile("s_waitcnt vmcnt(5)" ::: "memory"); else asm volatile("s_waitcnt vmcnt(0)" ::: "memory");
        __syncthreads();
        if (kt + 2 < SEQ / 64) { const int s2 = (st == 0) ? 2 : st - 1; MLA_DMA(kt + 2, s2); }
        const LAS unsigned char* kb = lds + st * STG + KOFF + r32 * 384;
        const LAS unsigned char* vb = lds + st * STG + vlane;
        f32x16 s0 = (f32x16){}, s1 = (f32x16){};
#pragma unroll
        for (int si = 0; si < 12; ++si) { const int off = ((2 * si + hh) ^ sw) << 4;
            const bf16x8 a0 = *(const LAS bf16x8*)(kb + off), a1 = *(const LAS bf16x8*)(kb + 32 * 384 + off);
            s0 = __builtin_amdgcn_mfma_f32_32x32x16_bf16(a0, qf[si], s0, 0, 0, 0);
            s1 = __builtin_amdgcn_mfma_f32_32x32x16_bf16(a1, qf[si], s1, 0, 0, 0); }
        float mx = fmaxf(s0[0], s1[0]);
#pragma unroll
        for (int r = 1; r < 16; ++r) mx = fmaxf(mx, fmaxf(s0[r], s1[r]));
        mx = fmaxf(mx, __shfl_xor(mx, 32));
        if (__any(mx > mref + 8.0f)) {
            const float mnew = fmaxf(mref, mx); const float f = __builtin_amdgcn_exp2f(mref - mnew);
            lsum *= f; mref = mnew;
            if (hh == 0) scr[r32] = f;
            LDS_WAIT(); asm volatile("" ::: "memory");
#pragma unroll
            for (int r = 0; r < 16; ++r) { const float fr_ = scr[crow0(r) + 4 * hh];
#pragma unroll
                for (int d = 0; d < 4; ++d) o[d][r] *= fr_; }
        }
        unsigned pw0[8], pw1[8]; float ps = 0.f;
#pragma unroll
        for (int r = 0; r < 16; r += 2) {
            const float a0 = __builtin_amdgcn_exp2f(s0[r] - mref), a1 = __builtin_amdgcn_exp2f(s0[r + 1] - mref);
            const float b0 = __builtin_amdgcn_exp2f(s1[r] - mref), b1 = __builtin_amdgcn_exp2f(s1[r + 1] - mref);
            ps += (a0 + a1) + (b0 + b1);
            pw0[r >> 1] = pg8::cvt_pk_bf16(a0, a1); pw1[r >> 1] = pg8::cvt_pk_bf16(b0, b1);
        }
        lsum += ps;
        bf16x8 pa[2][2];
        pa[0][0] = __builtin_bit_cast(bf16x8, (v4u){pw0[0], pw0[1], pw0[2], pw0[3]}); pa[0][1] = __builtin_bit_cast(bf16x8, (v4u){pw0[4], pw0[5], pw0[6], pw0[7]});
        pa[1][0] = __builtin_bit_cast(bf16x8, (v4u){pw1[0], pw1[1], pw1[2], pw1[3]}); pa[1][1] = __builtin_bit_cast(bf16x8, (v4u){pw1[4], pw1[5], pw1[6], pw1[7]});
#pragma unroll
        for (int dt = 0; dt < 4; ++dt)
#pragma unroll
            for (int st = 0; st < 2; ++st)
#pragma unroll
                for (int sh = 0; sh < 2; ++sh) {
                    const s16x4 lo = vtr(vb + ((4 * st + 2 * sh) * 4 + dt) * 512), hi = vtr(vb + ((4 * st + 2 * sh + 1) * 4 + dt) * 512);
                    const bf16x8 vv = (bf16x8){lo[0], lo[1], lo[2], lo[3], hi[0], hi[1], hi[2], hi[3]};
                    o[dt] = __builtin_amdgcn_mfma_f32_32x32x16_bf16(pa[st][sh], vv, o[dt], 0, 0, 0);
                }
        st = (st == 2) ? 0 : st + 1;
    }
#undef MLA_DMA
    lsum += __shfl_xor(lsum, 32);
    if (hh == 0) scr[32 + r32] = lsum;
    LDS_WAIT(); asm volatile("" ::: "memory");
#pragma unroll
    for (int r = 0; r < 16; ++r) {
        const int row = crow0(r) + 4 * hh; const float il = 1.f / scr[32 + row];
        bf16* op = Og + (rowbase + qb * 256 + wid * 32 + row) * 1024 + h * 128 + r32;
#pragma unroll
        for (int dt = 0; dt < 4; ++dt) op[dt * 32] = (bf16)f2bf(o[dt][r] * il);
    }
    __syncthreads();
}

#define INS16(L, xin) do { float xx_ = (xin); _Pragma("unroll") for (int i_ = 0; i_ < 16; ++i_) { const float t_ = vmaxf(L[i_], xx_); xx_ = vminf(L[i_], xx_); L[i_] = t_; } } while (0)
__device__ __forceinline__ void topk_unit(LAS unsigned char* lds, const bf16* __restrict__ Qp, const bf16* __restrict__ SK, int* seli, float* selg, int tt, int h) {
    int tid = threadIdx.x; asm volatile("" : "+v"(tid));
    const int lane = tid & 63, wid = __builtin_amdgcn_readfirstlane(tid >> 6);
    const int r32 = lane & 31, hh = lane >> 5, sw = r32 & 7;
    const int token = tt * 256 + wid * 32 + r32;
    float AB[2][16];
#pragma unroll
    for (int c = 0; c < 2; ++c) {
        __syncthreads();
#pragma unroll
        for (int i = 0; i < 4; ++i) { const int cc = tid + 512 * i, row = cc >> 4, ch = cc & 15;
            const v4u v = *(const GAS v4u*)(SK + ((size_t)(h * 2 + c) * 128 + row) * 128 + ch * 8);
            *(LAS v4u*)(lds + row * 256 + ((ch ^ (row & 7)) << 4)) = v; }
        bf16x8 qf[8];
#pragma unroll
        for (int s = 0; s < 8; ++s) qf[s] = *(const GAS bf16x8*)(Qp + (size_t)token * 2048 + h * 256 + c * 128 + 16 * s + 8 * hh);
        __syncthreads();
        float L[16];
#pragma unroll
        for (int kt = 0; kt < 4; ++kt) {
            f32x16 acc = (f32x16){};
#pragma unroll
            for (int s = 0; s < 8; ++s) { const bf16x8 a = *(const LAS bf16x8*)(lds + (kt * 32 + r32) * 256 + (((2 * s + hh) ^ sw) << 4));
                acc = __builtin_amdgcn_mfma_f32_32x32x16_bf16(a, qf[s], acc, 0, 0, 0); }
            float G[16];
#pragma unroll
            for (int r = 0; r < 16; ++r) { const unsigned key = (unsigned)(kt * 32 + crow0(r)) + 4u * (unsigned)hh;
                const float av = acc[r];
                G[r] = __builtin_bit_cast(float, (__builtin_bit_cast(unsigned, av) & ~127u) | key); }
#pragma unroll
            for (int k = 2; k <= 16; k <<= 1)
#pragma unroll
                for (int j = k >> 1; j >= 1; j >>= 1)
#pragma unroll
                    for (int i = 0; i < 16; ++i) { const int l = i ^ j; if (l > i) { const float hi_ = vmaxf(G[i], G[l]), lo_ = vminf(G[i], G[l]); if ((i & k) == 0) { G[i] = hi_; G[l] = lo_; } else { G[i] = lo_; G[l] = hi_; } } }
            if (kt == 0) {
#pragma unroll
                for (int i = 0; i < 16; ++i) L[i] = G[i];
            } else {
#pragma unroll
                for (int i = 0; i < 16; ++i) L[i] = vmaxf(L[i], G[15 - i]);
#pragma unroll
                for (int d = 8; d >= 1; d >>= 1)
#pragma unroll
                    for (int i = 0; i < 16; ++i) if ((i & d) == 0) { const float a = vmaxf(L[i], L[i + d]), bq = vminf(L[i], L[i + d]); L[i] = a; L[i + d] = bq; }
            }
        }
        float M[16];
#pragma unroll
        for (int i = 0; i < 16; ++i) M[i] = vmaxf(L[i], __shfl_xor(L[15 - i], 32));
#pragma unroll
        for (int d = 8; d >= 1; d >>= 1)
#pragma unroll
            for (int i = 0; i < 16; ++i) if ((i & d) == 0) { const float a = vmaxf(M[i], M[i + d]), bq = vminf(M[i], M[i + d]); M[i] = a; M[i + d] = bq; }
#pragma unroll
        for (int i = 0; i < 16; ++i) AB[c][i] = M[i];
    }
    float W[16];
#pragma unroll
    for (int j = 0; j < 16; ++j) { const float sum = AB[0][0] + AB[1][j]; const float x = __builtin_bit_cast(float, (__builtin_bit_cast(unsigned, sum) & ~255u) | (unsigned)j); W[j] = hh ? -INFINITY : x; }
    {
        float cand[34]; int nc = 0;
#pragma unroll
        for (int i = 1; i < 16; ++i)
#pragma unroll
            for (int j = 0; j < 16; ++j) if ((i + 1) * (j + 1) <= 16) { const float sum = AB[0][i] + AB[1][j];
                cand[nc++] = __builtin_bit_cast(float, (__builtin_bit_cast(unsigned, sum) & ~255u) | (unsigned)(i * 16 + j)); }
#pragma unroll
        for (int c = 0; c < 17; ++c) { float xe = cand[2 * c], xo = cand[2 * c + 1]; asm volatile("" : "+v"(xe), "+v"(xo)); const float x = hh ? xo : xe; INS16(W, x); }
#pragma unroll
        for (int i = 0; i < 16; ++i) cand[i] = __shfl_xor(W[15 - i], 32);
#pragma unroll
        for (int i = 0; i < 16; ++i) W[i] = vmaxf(W[i], cand[i]);
#pragma unroll
        for (int d = 8; d >= 1; d >>= 1)
#pragma unroll
            for (int i = 0; i < 16; ++i) if ((i & d) == 0) { const float a = vmaxf(W[i], W[i + d]), bq = vminf(W[i], W[i + d]); W[i] = a; W[i + d] = bq; }
    }
    LAS unsigned char* tb = lds + 32768 + wid * 1024 + r32 * 32;
    if (hh == 0) {
#pragma unroll
        for (int c = 0; c < 2; ++c)
#pragma unroll
            for (int q = 0; q < 4; ++q) { unsigned w = 0;
#pragma unroll
                for (int e = 0; e < 4; ++e) w |= (__builtin_bit_cast(unsigned, AB[c][4 * q + e]) & 127u) << (8 * e);
                *(LAS unsigned*)(tb + c * 16 + 4 * q) = w; }
    }
    LDS_WAIT(); asm volatile("" ::: "memory");
    float Z = 0.f;
#pragma unroll
    for (int k = 0; k < 16; ++k) Z += __expf(W[k] - W[0]);
    const float iz = 1.f / Z;
    int ei[8]; float eg[8];
#pragma unroll
    for (int k = 0; k < 8; ++k) {
        float wa_ = W[k], wb_ = W[8 + k]; asm volatile("" : "+v"(wa_), "+v"(wb_));
        const float w = hh ? wb_ : wa_;
        const unsigned ij = __builtin_bit_cast(unsigned, w) & 255u;
        const unsigned k1 = tb[ij >> 4], k2 = tb[16 + (ij & 15)];
        ei[k] = (int)(k1 * 128u + k2); eg[k] = __expf(w - W[0]) * iz;
    }
    int* ip = seli + (size_t)token * 128 + h * 16 + 8 * hh; float* gp = selg + (size_t)token * 128 + h * 16 + 8 * hh;
    *(GAS v4u*)ip = (v4u){(unsigned)ei[0], (unsigned)ei[1], (unsigned)ei[2], (unsigned)ei[3]}; *(GAS v4u*)(ip + 4) = (v4u){(unsigned)ei[4], (unsigned)ei[5], (unsigned)ei[6], (unsigned)ei[7]};
    *(GAS f32x4*)gp = (f32x4){eg[0], eg[1], eg[2], eg[3]}; *(GAS f32x4*)(gp + 4) = (f32x4){eg[4], eg[5], eg[6], eg[7]};
}

__device__ __forceinline__ void topk_brute_unit(LAS unsigned char* lds, const bf16* __restrict__ Qp, const bf16* __restrict__ SK, int* seli, float* selg, int tt, int h) {
    const int tid = threadIdx.x;
    const int token = tt * 512 + tid;
    float AB[2][16];
#pragma unroll
    for (int c = 0; c < 2; ++c) {
        __syncthreads();
#pragma unroll
        for (int i = 0; i < 4; ++i) { const int cc = tid + 512 * i, row = cc >> 4, ch = cc & 15;
            const v4u v = *(const GAS v4u*)(SK + ((size_t)(h * 2 + c) * 128 + row) * 128 + ch * 8);
            *(LAS v4u*)(lds + row * 256 + (ch << 4)) = v; }
        __syncthreads();
        unsigned q[64];
#pragma unroll
        for (int i = 0; i < 16; ++i) { const v4u v = *(const GAS v4u*)(Qp + (size_t)token * 2048 + h * 256 + c * 128 + i * 8); q[4 * i] = v.x; q[4 * i + 1] = v.y; q[4 * i + 2] = v.z; q[4 * i + 3] = v.w; }
        float L[16];
#pragma unroll
        for (int i = 0; i < 16; ++i) L[i] = -INFINITY;
#pragma unroll 1
        for (int key = 0; key < 128; ++key) {
            float s = 0.f;
#pragma unroll
            for (int i = 0; i < 64; ++i) { const unsigned kw = *(const LAS unsigned*)(lds + key * 256 + i * 4);
                s += __builtin_bit_cast(float, kw << 16) * __builtin_bit_cast(float, q[i] << 16) + __builtin_bit_cast(float, kw & 0xffff0000u) * __builtin_bit_cast(float, q[i] & 0xffff0000u); }
            const float x = __builtin_bit_cast(float, (__builtin_bit_cast(unsigned, s) & ~127u) | (unsigned)key); INS16(L, x);
        }
#pragma unroll
        for (int i = 0; i < 16; ++i) AB[c][i] = L[i];
    }
    float W[16];
#pragma unroll
    for (int i = 0; i < 16; ++i) W[i] = -INFINITY;
#pragma unroll
    for (int i = 0; i < 16; ++i)
#pragma unroll
        for (int j = 0; j < 16; ++j) if ((i + 1) * (j + 1) <= 16) {
            const float sum = AB[0][i] + AB[1][j];
            const float x = __builtin_bit_cast(float, (__builtin_bit_cast(unsigned, sum) & ~255u) | (unsigned)(i * 16 + j)); INS16(W, x); }
    __syncthreads();
    LAS unsigned char* tb = lds + tid * 32;
#pragma unroll
    for (int c = 0; c < 2; ++c)
#pragma unroll
        for (int qd = 0; qd < 4; ++qd) { unsigned w = 0;
#pragma unroll
            for (int e = 0; e < 4; ++e) w |= (__builtin_bit_cast(unsigned, AB[c][4 * qd + e]) & 127u) << (8 * e);
            *(LAS unsigned*)(tb + c * 16 + 4 * qd) = w; }
    LDS_WAIT(); asm volatile("" ::: "memory");
    float Z = 0.f;
#pragma unroll
    for (int k = 0; k < 16; ++k) Z += __expf(W[k] - W[0]);
    const float iz = 1.f / Z;
#pragma unroll
    for (int k = 0; k < 16; ++k) {
        const unsigned ij = __builtin_bit_cast(unsigned, W[k]) & 255u;
        const unsigned k1 = tb[ij >> 4], k2 = tb[16 + (ij & 15)];
        seli[(size_t)token * 128 + h * 16 + k] = (int)(k1 * 128u + k2); selg[(size_t)token * 128 + h * 16 + k] = __expf(W[k] - W[0]) * iz;
    }
}

typedef float f32x2 __attribute__((ext_vector_type(2)));
#ifndef PGV_SYNC
#define PGV_SYNC 4
#endif
constexpr float PEER_CSC = 32.0f;
constexpr float PEER_TSCALE = 256.0f;
__device__ __forceinline__ float reduce8(const float (&p)[8], int lane) {
    const bool h5 = (lane & 32) != 0, h4 = (lane & 16) != 0, h3 = (lane & 8) != 0;
    float q[4], r[2];
#pragma unroll
    for (int j = 0; j < 4; ++j) { const float send = h5 ? p[j] : p[4 + j], keep = h5 ? p[4 + j] : p[j]; q[j] = keep + __shfl_xor(send, 32); }
#pragma unroll
    for (int j = 0; j < 2; ++j) { const float send = h4 ? q[j] : q[2 + j], keep = h4 ? q[2 + j] : q[j]; r[j] = keep + __shfl_xor(send, 16); }
    const float send = h3 ? r[0] : r[1], keep = h3 ? r[1] : r[0];
    float s = keep + __shfl_xor(send, 8);
    s += __shfl_xor(s, 4); s += __shfl_xor(s, 2); s += __shfl_xor(s, 1);
    return s;
}
typedef long i64_t;
__device__ __forceinline__ i64_t mk64(unsigned lo, unsigned hi) { return (i64_t)(((unsigned long long)hi << 32) | (unsigned long long)lo); }
template <int variant>
__device__ __forceinline__ void peer_gather(const Frame& F, float* H, bf16* HB, const int* seli, const float* selg, const unsigned char* __restrict__ PU, const unsigned char* __restrict__ PV, const float* lng, const float* lnb,
                                            const float* STAT, const float* g1, const float* b1) {
    int lane = F.lane; asm volatile("" : "+v"(lane));
    const int gw = F.vcu * NWAVES + F.wave, NGW = F.G * NWAVES, r16 = lane & 15, kg = lane >> 4;
#ifndef ABL_PEER
#define ABL_PEER 1.0f
#endif
    LAS unsigned char* wb = F.lds + F.wave * 16384;
    LAS unsigned char* x8 = wb;
    LAS unsigned short* elist = (LAS unsigned short*)(wb + 4096);
    LAS unsigned char* tlist = wb + 5120;
    LAS float* dc = (LAS float*)(wb + 5632);
    LAS unsigned short* posT = (LAS unsigned short*)(wb + 7680);
    LAS int* cnt = (LAS int*)(wb + 8704);
    LAS int* gtab = (LAS int*)(wb + 9216);
    LAS int* otab = (LAS int*)(wb + 9728);
    LAS float* dd = (LAS float*)(wb + 10240);
#pragma unroll 1
    for (int round = 0; round < 2; ++round) {
        {
            int ia[4], ib[4], pa[4], pb[4]; float ga[4], gb[4];
#pragma unroll
            for (int i = 0; i < 4; ++i) { const size_t o = (size_t)(gw + NGW * (4 * round + i)) * 128 + lane; ia[i] = seli[o]; ib[i] = seli[o + 64]; ga[i] = selg[o]; gb[i] = selg[o + 64]; }
            cnt[lane] = 0; cnt[64 + lane] = 0;
            LDS_WAIT(); asm volatile("" ::: "memory");
#pragma unroll
            for (int i = 0; i < 4; ++i) { pa[i] = __hip_atomic_fetch_add(cnt + (ia[i] >> 9) * 4 + i, 1, __ATOMIC_RELAXED, __HIP_MEMORY_SCOPE_WORKGROUP);
                                          pb[i] = __hip_atomic_fetch_add(cnt + (ib[i] >> 9) * 4 + i, 1, __ATOMIC_RELAXED, __HIP_MEMORY_SCOPE_WORKGROUP); }
            LDS_WAIT(); asm volatile("" ::: "memory");
            { const int n0 = cnt[2 * lane], n1 = cnt[2 * lane + 1]; int s = n0 + n1;
#pragma unroll
              for (int d = 1; d < 64; d <<= 1) { const int tt = __shfl_up(s, d); if (lane >= d) s += tt; }
              const int base = s - n0 - n1;
              int pk = 0;
              if (lane < 32) {
#pragma unroll
                  for (int i = 0; i < 4; ++i) pk |= cnt[lane * 4 + i] << (8 * i); }
              int ps = pk;
#pragma unroll
              for (int d = 1; d < 32; d <<= 1) { const int tt = __shfl_up(ps, d); if (lane >= d) ps += tt; }
              ps -= pk;
              LDS_WAIT(); asm volatile("" ::: "memory");
              gtab[2 * lane] = base; gtab[2 * lane + 1] = base + n0;
              if (lane < 32) {
#pragma unroll
                  for (int i = 0; i < 4; ++i) otab[i * 32 + lane] = (ps >> (8 * i)) & 255; } }
            LDS_WAIT(); asm volatile("" ::: "memory");
#pragma unroll
            for (int i = 0; i < 4; ++i) { const int wa = ia[i] >> 9, wb_ = ib[i] >> 9;
                const int qa = gtab[wa * 4 + i] + pa[i], qb = gtab[wb_ * 4 + i] + pb[i], sa = otab[i * 32 + wa] + pa[i], sb = otab[i * 32 + wb_] + pb[i];
                elist[qa] = (unsigned short)ia[i]; elist[qb] = (unsigned short)ib[i]; tlist[qa] = (unsigned char)i; tlist[qb] = (unsigned char)i; dc[qa] = ga[i]; dc[qb] = gb[i];
                posT[i * 128 + sa] = (unsigned short)qa; posT[i * 128 + sb] = (unsigned short)qb; }
#pragma unroll
            for (int i = 0; i < 4; ++i) { const bf16* xp = HB + (size_t)(gw + NGW * (4 * round + i)) * DM + 16 * lane;
                const v4u xa = *(const GAS v4u*)xp, xb = *(const GAS v4u*)(xp + 8);
                const unsigned w0 = xa.x, w1 = xa.y, w2 = xa.z, w3 = xa.w, w4 = xb.x, w5 = xb.y, w6 = xb.z, w7 = xb.w;
#define LOF(w) __builtin_bit_cast(float, (w) << 16)
#define HIF(w) __builtin_bit_cast(float, (w) & 0xffff0000u)
#define PK4(wa, wb_) __builtin_amdgcn_cvt_pk_fp8_f32(LOF(wb_), HIF(wb_), __builtin_amdgcn_cvt_pk_fp8_f32(LOF(wa), HIF(wa), 0, false), true)
                const v4u o = (v4u){(unsigned)PK4(w0, w1), (unsigned)PK4(w2, w3), (unsigned)PK4(w4, w5), (unsigned)PK4(w6, w7)};
#undef PK4
#undef LOF
#undef HIF
                *(LAS v4u*)(x8 + i * 1024 + 16 * lane) = o; }
        }
        LDS_WAIT(); asm volatile("" ::: "memory");
        {
#define PGU_LOAD(buf, EV, TV, g_) do { EV = (int)elist[8 * (g_) + (lane & 7)]; TV = (int)tlist[8 * (g_) + (lane & 7)]; \
            _Pragma("unroll") for (int k = 0; k < 8; ++k) { const int idx = __builtin_amdgcn_readlane(EV, k); buf[k] = *(const GAS v4u*)(PU + (size_t)idx * DM + 16 * lane); } } while (0)
#define PGU_COMP(buf, TV, g_) do { float p_[8]; v4u xa_[8]; f32x4 D_[8]; \
            _Pragma("unroll") for (int k = 0; k < 8; ++k) { const int tk_ = __builtin_amdgcn_readlane(TV, k); xa_[k] = *(const LAS v4u*)(x8 + tk_ * 1024 + 16 * lane); } \
            _Pragma("unroll") for (int k = 0; k < 8; ++k) { const unsigned a0 = xa_[k].x, a1 = xa_[k].y, b0 = buf[k].x, b1 = buf[k].y; \
                D_[k] = __builtin_amdgcn_mfma_f32_16x16x32_fp8_fp8(mk64(a0, a1), mk64(b0, b1), (f32x4){0.f, 0.f, 0.f, 0.f}, 0, 0, 0); } \
            _Pragma("unroll") for (int k = 0; k < 8; ++k) { const unsigned a2 = xa_[k].z, a3 = xa_[k].w, b2 = buf[k].z, b3 = buf[k].w; \
                D_[k] = __builtin_amdgcn_mfma_f32_16x16x32_fp8_fp8(mk64(a2, a3), mk64(b2, b3), D_[k], 0, 0, 0); } \
            _Pragma("unroll") for (int k = 0; k < 8; ++k) { const float da_ = D_[k][0], db_ = D_[k][1], dc_ = D_[k][2], dd_ = D_[k][3]; p_[k] = (da_ * tw0 + db_ * tw1) + (dc_ * tw2 + dd_ * tw3); } \
            const float tot_ = reduce8(p_, lane); \
            if ((lane & 7) == 0) dd[8 * (g_) + (lane >> 3)] = tot_ * (1.0f / PEER_TSCALE); } while (0)
            const float tw0 = (kg == (r16 >> 2) && (r16 & 3) == 0) ? 1.f : 0.f, tw1 = (kg == (r16 >> 2) && (r16 & 3) == 1) ? 1.f : 0.f,
                        tw2 = (kg == (r16 >> 2) && (r16 & 3) == 2) ? 1.f : 0.f, tw3 = (kg == (r16 >> 2) && (r16 & 3) == 3) ? 1.f : 0.f;
            v4u bA[8], bB[8]; int EA, EB, TA, TB;
            PGU_LOAD(bA, EA, TA, 0);
#pragma unroll 1
            for (int g = 0; g < 64; g += 2) {
                PGU_LOAD(bB, EB, TB, g + 1);
                PGU_COMP(bA, TA, g);
                if (g + 2 < 64) PGU_LOAD(bA, EA, TA, g + 2);
                PGU_COMP(bB, TB, g + 1);
#ifdef PGU_SYNC
                if ((g & (PGU_SYNC - 1)) == 0) __builtin_amdgcn_s_barrier();
#endif
            }
#undef PGU_LOAD
#undef PGU_COMP
        }
        LDS_WAIT(); asm volatile("" ::: "memory");
#pragma unroll
        for (int j = 0; j < 8; ++j) { const int gp = 64 * j + lane; const float d_ = dd[gp]; dc[gp] = fminf(fmaxf(PEER_CSC * dc[gp] * 0.5f * d_ * (1.f + erff(d_ * 0.70710678118654752f)), -448.f), 448.f); }
        LDS_WAIT(); asm volatile("" ::: "memory");
        typedef unsigned v2u_t __attribute__((ext_vector_type(2)));
        LAS v2u_t* ec = (LAS v2u_t*)(wb + 12288);
#pragma unroll
        for (int j = 0; j < 8; ++j) { const int n = 64 * j + lane; const int pos = (int)posT[n]; const float cf_ = dc[pos];
            const unsigned c8 = (unsigned)__builtin_amdgcn_cvt_pk_fp8_f32(cf_, cf_, 0, false) & 0xffu; ec[n] = (v2u_t){(unsigned)elist[pos], c8 * 0x01010101u}; }
        LDS_WAIT(); asm volatile("" ::: "memory");
        {
            const int q = lane >> 4, s16 = lane & 15;
            unsigned m1lo, m1hi, m2lo, m2hi;
            { const unsigned bm = 0xffu << (8 * (s16 & 3)); const bool lo_ = (s16 & 7) < 4; const bool s1 = q == (s16 >> 3), s2 = q == 2 + (s16 >> 3);
              m1lo = (s1 && lo_) ? bm : 0u; m1hi = (s1 && !lo_) ? bm : 0u; m2lo = (s2 && lo_) ? bm : 0u; m2hi = (s2 && !lo_) ? bm : 0u; }
            const LAS v2u_t* ecq = ec + q * 128;
            const unsigned char* pvl = PV + 16 * s16;
            f32x4 D[4][2][2];
#pragma unroll
            for (int j = 0; j < 4; ++j)
#pragma unroll
                for (int h = 0; h < 2; ++h) { D[j][h][0] = (f32x4){0.f, 0.f, 0.f, 0.f}; D[j][h][1] = (f32x4){0.f, 0.f, 0.f, 0.f}; }
            v4u rb[4][4]; unsigned cb[4];
#define PGV_LOAD(b_, e_) do { const v2u_t ic_ = ecq[(e_) < 128 ? (e_) : 127]; const unsigned ix_ = ic_.x, cy_ = ic_.y; cb[b_] = ((e_) < 128) ? cy_ : 0u; const unsigned char* rp_ = pvl + (size_t)ix_ * DM; \
            _Pragma("unroll") for (int j = 0; j < 4; ++j) rb[b_][j] = *(const GAS v4u*)(rp_ + 256 * j); } while (0)
#define PGV_COMP(b_) do { const unsigned c4 = cb[b_]; const i64_t a1 = mk64(c4 & m1lo, c4 & m1hi), a2 = mk64(c4 & m2lo, c4 & m2hi); \
            _Pragma("unroll") for (int j = 0; j < 4; ++j) { const unsigned b0 = rb[b_][j].x, b1 = rb[b_][j].y, b2 = rb[b_][j].z, b3 = rb[b_][j].w; const i64_t blo = mk64(b0, b1), bhi = mk64(b2, b3); \
                D[j][0][0] = __builtin_amdgcn_mfma_f32_16x16x32_fp8_fp8(a1, blo, D[j][0][0], 0, 0, 0); D[j][0][1] = __builtin_amdgcn_mfma_f32_16x16x32_fp8_fp8(a2, blo, D[j][0][1], 0, 0, 0); \
                D[j][1][0] = __builtin_amdgcn_mfma_f32_16x16x32_fp8_fp8(a1, bhi, D[j][1][0], 0, 0, 0); D[j][1][1] = __builtin_amdgcn_mfma_f32_16x16x32_fp8_fp8(a2, bhi, D[j][1][1], 0, 0, 0); } } while (0)
            PGV_LOAD(0, 0); PGV_LOAD(1, 1); PGV_LOAD(2, 2);
#pragma unroll 1
            for (int e0 = 0; e0 < 128; e0 += 4) {
                PGV_LOAD(3, e0 + 3); __builtin_amdgcn_sched_barrier(0); PGV_COMP(0); __builtin_amdgcn_sched_barrier(0);
                if (PGV_SYNC == 1) __builtin_amdgcn_s_barrier();
                PGV_LOAD(0, e0 + 4); __builtin_amdgcn_sched_barrier(0); PGV_COMP(1); __builtin_amdgcn_sched_barrier(0);
                if (PGV_SYNC <= 2) __builtin_amdgcn_s_barrier();
                PGV_LOAD(1, e0 + 5); __builtin_amdgcn_sched_barrier(0); PGV_COMP(2); __builtin_amdgcn_sched_barrier(0);
                if (PGV_SYNC == 1) __builtin_amdgcn_s_barrier();
                PGV_LOAD(2, e0 + 6); __builtin_amdgcn_sched_barrier(0); PGV_COMP(3); __builtin_amdgcn_sched_barrier(0);
                if (PGV_SYNC <= 4 || (e0 & (PGV_SYNC - 1)) == 0) __builtin_amdgcn_s_barrier();
            }
#undef PGV_LOAD
#undef PGV_COMP
            constexpr float YS = ABL_PEER / (PEER_TSCALE * PEER_CSC);
            const int cb_ = 16 * s16 + 4 * (q & 1);
#pragma unroll
            for (int s = 0; s < 2; ++s) {
                const int t = gw + NGW * (4 * round + 2 * s + (lane >> 5));
                float* hrow = H + (size_t)t * DM + cb_;
                const f32x2 st_ = *(const GAS f32x2*)(STAT + 2 * (size_t)t); const float mu1 = st_.x, rs1 = st_.y * DN_ALPHA;
                float sm = 0.f;
#pragma unroll
                for (int j = 0; j < 4; ++j)
#pragma unroll
                    for (int h = 0; h < 2; ++h) { const int co = 256 * j + 8 * h; const f32x4 g1_ = *(const GAS f32x4*)(g1 + cb_ + co), b1_ = *(const GAS f32x4*)(b1 + cb_ + co);
                        const f32x4 v_ = ((*(const GAS f32x4*)(hrow + co) - mu1) * rs1 * g1_ + b1_ * DN_ALPHA) + D[j][h][s] * YS; D[j][h][s] = v_; sm += (v_.x + v_.y) + (v_.z + v_.w); }
#pragma unroll
                for (int of = 1; of < 32; of <<= 1) sm += __shfl_xor(sm, of);
                const float mean = sm * (1.f / DM); float s2 = 0.f;
#pragma unroll
                for (int j = 0; j < 4; ++j)
#pragma unroll
                    for (int h = 0; h < 2; ++h) { const f32x4 v_ = D[j][h][s] - mean; D[j][h][s] = v_; s2 += (v_.x * v_.x + v_.y * v_.y) + (v_.z * v_.z + v_.w * v_.w); }
#pragma unroll
                for (int of = 1; of < 32; of <<= 1) s2 += __shfl_xor(s2, of);
                const float rstd = __builtin_amdgcn_rsqf(s2 * (1.f / DM) + LN_EPS);
                bf16* brow = HB + (size_t)t * DM + cb_;
#pragma unroll
                for (int j = 0; j < 4; ++j)
#pragma unroll
                    for (int h = 0; h < 2; ++h) { const int co = 256 * j + 8 * h;
                        const f32x4 gv_ = *(const GAS f32x4*)(lng + cb_ + co), bv_ = *(const GAS f32x4*)(lnb + cb_ + co);
                        const f32x4 o_ = D[j][h][s] * rstd * gv_ + bv_;
                        *(GAS f32x4*)(hrow + co) = o_;
                        *(GAS v2u_t*)(brow + co) = (v2u_t){pk2(o_.x, o_.y), pk2(o_.z, o_.w)}; }
            }
        }
    }
}
#ifndef RET_UNIT
#define RET_UNIT ret_unitpx
#endif
#ifndef MK_SINGLE
#define MK_SINGLE 1
#endif
constexpr int NPH = 17;
#ifndef GV2
#define GV2 0
#endif
#ifndef ABL_RET
#define ABL_RET 1.0f
#endif
#ifndef ABL_MLA
#define ABL_MLA 1.0f
#endif
struct Args { const void* in[21]; float* out; unsigned char* ws; int ph_lo, ph_hi; };
__global__ void __launch_bounds__(NWAVES * 64, 2) mk_fwd(Args args) {
    extern __shared__ __attribute__((aligned(16))) unsigned char lds[];
    Frame F;
    F.lds = (LAS unsigned char*)lds;
    volatile LAS unsigned* MISC = (volatile LAS unsigned*)(F.lds + MISC_OFF);
    F.tid = threadIdx.x; F.lane = F.tid & 63; F.wave = __builtin_amdgcn_readfirstlane(F.tid >> 6);
    F.G = gridDim.x; { const int bx = blockIdx.x; F.vcu = (F.G % 8 == 0) ? (bx % 8) * (F.G / 8) + bx / 8 : bx; }
    Ptrs P;
    P.x = (const float*)args.in[0]; P.pos = (const int*)args.in[1];
    P.ret_w_in = (const float*)args.in[2]; P.ret_decay = (const float*)args.in[3]; P.ret_gn_g = (const float*)args.in[4]; P.ret_gn_b = (const float*)args.in[5]; P.ret_w_out = (const float*)args.in[6];
    P.mla_w_in = (const float*)args.in[7]; P.mla_qn = (const float*)args.in[8]; P.mla_kvn = (const float*)args.in[9]; P.mla_w_uq = (const float*)args.in[10]; P.mla_w_ukv = (const float*)args.in[11]; P.mla_w_out = (const float*)args.in[12];
    P.peer_w_q = (const float*)args.in[13]; P.peer_sk = (const float*)args.in[14]; P.peer_u = (const float*)args.in[15]; P.peer_v = (const float*)args.in[16];
    P.ln_mix_g = (const float*)args.in[17]; P.ln_mix_b = (const float*)args.in[18]; P.ln_ffn_g = (const float*)args.in[19]; P.ln_ffn_b = (const float*)args.in[20];
    P.H = args.out; P.ws = args.ws;
    unsigned char* ws = args.ws;
    gu32* ctl = (gu32*)(ws + WS_CTL);
    for (int u = F.tid; u < (LDS_BYTES - LDSCTL_OFF) / 4; u += NWAVES * 64) ((LAS unsigned*)(F.lds + LDSCTL_OFF))[u] = 0u;
    __syncthreads();
    const int lo = args.ph_lo, hi = args.ph_hi;
    XcdBarrier bar; bar.bar = (unsigned*)(ctl + CW_BAR); bar.x = 0; bar.st = nullptr;
    if (hi - lo > 1) bar = xcd_barrier_post((unsigned*)(ctl + CW_BAR), MISC + 8);
#ifndef PHMASK
#define PHMASK 0x1ffff
#endif
#define IN(k) ((((PHMASK) >> (k)) & 1) && lo <= (k) && (k) < hi)
#define SEAM(k) do { if (IN(k) && IN((k) + 1)) xcd_barrier(bar); } while (0)
#ifndef REP
#define REP -1
#endif
#ifndef REPVAR
#define REPVAR 0
#endif
#define NREP(k) ((REP) == (k) ? 2 : 1)
#define REPBAR(k) do { if (rep + 1 < NREP(k)) xcd_barrier(bar); } while (0)
    float* const STAT = (float*)(ws + WS_CTL + 512 * 1024);
    float* const DUMH = (float*)(ws + 424 * MiB); bf16* const DUMB = (bf16*)(ws + 424 * MiB);
    bf16* HB = (bf16*)(ws + WS_HB);
    int* SELI = (int*)(ws + WS_SELI); float* SELG = (float*)(ws + WS_SELG);

    if (IN(0)) for (int rep = 0; rep < NREP(0); ++rep) { p0_prologue(F, P); REPBAR(0); } SEAM(0);
    if (IN(1)) for (int rep = 0; rep < NREP(1); ++rep) {
        pg8::Gemm g{HB, (const bf16*)(ws + WS_W_RIN), T, 6144, 1024}; pg8::StaticOrder S; S.init(T, 6144, F.G, (int)blockIdx.x);
        pg8::EpiRetIn E{(bf16*)(ws + WS_RQ), (bf16*)(ws + WS_RK), (bf16*)(ws + WS_RV), (bf16*)(ws + WS_RG), P.pos};
        pg8::gemm_phase<pg8::EpiRetIn, pg8::StaticOrder, true, true>(F.lds, g, S, E);
    REPBAR(1); } SEAM(1);
    if (IN(2)) for (int rep = 0; rep < NREP(2); ++rep) {
        unsigned m8 = 0, m9 = 0; if (F.tid == 0) { m8 = MISC[8]; m9 = MISC[9]; }
        for (int u = F.vcu; u < 512; u += F.G) {
            const int bh = u >> 4, qb = u & 15, b = bh >> 2, h = bh & 3;
            const float lf = log1pf(-expf(P.ret_decay[h])) * 1.4426950408889634f, lb = log1pf(-expf(P.ret_decay[4 + h])) * 1.4426950408889634f;
            RET_UNIT(F.lds, (const bf16*)(ws + WS_RQ), (const bf16*)(ws + WS_RK), (const bf16*)(ws + WS_RV), rep ? DUMB : (bf16*)(ws + WS_RG), P.ret_gn_g, P.ret_gn_b, lf, lb, b, h, qb, P.peer_u, P.peer_v, ws + WS_PU, u);
        }
        if (F.tid == 0) { MISC[8] = m8; MISC[9] = m9; } __syncthreads();
    REPBAR(2); } SEAM(2);
    if (IN(3)) for (int rep = 0; rep < NREP(3); ++rep) {
        pg8::Gemm g{(const bf16*)(ws + WS_RG), (const bf16*)(ws + WS_W_ROUT), T, 1024, 2048}; pg8::StaticOrder S; S.init(T, 1024, F.G, (int)blockIdx.x);
        pg8::EpiRes E{P.x, P.H, DN_ALPHA, ABL_RET};
        pg8::gemm_phase<pg8::EpiRes, pg8::StaticOrder, true, true>(F.lds, g, S, E);
    REPBAR(3); } SEAM(3);
    if (IN(4)) for (int rep = 0; rep < NREP(4); ++rep) { ln_rows(F, P.H, rep ? DUMB : HB, P.ln_mix_g, P.ln_mix_b, STAT); REPBAR(4); } SEAM(4);
    if (IN(5)) for (int rep = 0; rep < NREP(5); ++rep) {
        pg8::Gemm g{HB, (const bf16*)(ws + WS_W_PQ), T, 2048, 1024}; pg8::StaticOrder S; S.init(T, 2048, F.G, (int)blockIdx.x);
        pg8::EpiBf E{(bf16*)(ws + WS_QP), 2048};
        pg8::gemm_phase<pg8::EpiBf, pg8::StaticOrder, true, true>(F.lds, g, S, E);
    REPBAR(5); } SEAM(5);
    if (IN(6)) for (int rep = 0; rep < NREP(6); ++rep) {
#ifdef TOPK_BRUTE
        for (int u = F.vcu; u < 256; u += F.G) topk_brute_unit(F.lds, (const bf16*)(ws + WS_QP), (const bf16*)(ws + WS_W_SK), SELI, SELG, u >> 3, u & 7);
#else
        for (int u = F.vcu, ui = 0; u < 512; u += F.G, ++ui) topk_unit(F.lds, (const bf16*)(ws + WS_QP), (const bf16*)(ws + WS_W_SK), SELI, SELG, u >> 3, u & 7);
#endif
    REPBAR(6); } SEAM(6);
    if (IN(7)) for (int rep = 0; rep < NREP(7); ++rep) { peer_gather<GV2>(F, P.H, HB, SELI, SELG, ws + WS_PU, ws + WS_PV, P.ln_ffn_g, P.ln_ffn_b, STAT, P.ln_mix_g, P.ln_mix_b);
#ifdef GVAR
        xcd_barrier(bar); peer_gather<GVAR>(F, (float*)(ws + 424 * MiB), (bf16*)(ws + 424 * MiB), SELI, SELG, ws + WS_PU, ws + WS_PV, P.ln_ffn_g, P.ln_ffn_b, STAT, P.ln_mix_g, P.ln_mix_b);
#endif
 REPBAR(7); } SEAM(7);
    if (IN(8)) for (int rep = 0; rep < NREP(8); ++rep) {
        pg8::Gemm g{HB, (const bf16*)(ws + WS_W_MIN), T, 768, 1024}; pg8::StaticOrder S; S.init(T, 768, F.G, (int)blockIdx.x);
        pg8::EpiF32 E{(float*)(ws + WS_MC), 768};
        pg8::gemm_phase<pg8::EpiF32, pg8::StaticOrder, true, true>(F.lds, g, S, E);
    REPBAR(8); } SEAM(8);
    if (IN(9)) for (int rep = 0; rep < NREP(9); ++rep) { mla_rows(F, P); REPBAR(9); } SEAM(9);
    if (IN(10)) for (int rep = 0; rep < NREP(10); ++rep) {
        { pg8::Gemm g{(const bf16*)(ws + WS_CQN), (const bf16*)(ws + WS_W_UQ), T, 1536, 384}; pg8::StaticOrder S; S.init(T, 1536, F.G, (int)blockIdx.x);
          pg8::EpiUq E{(bf16*)(ws + WS_MQ), P.pos, MLA_QS};
          pg8::gemm_phase<pg8::EpiUq, pg8::StaticOrder, true, true>(F.lds, g, S, E); }
        { pg8::Gemm g{(const bf16*)(ws + WS_CKVN), (const bf16*)(ws + WS_W_UKV), T, 2048, 256}; pg8::StaticOrder S; S.init(T, 2048, F.G, (int)blockIdx.x);
          pg8::EpiBf E{(bf16*)(ws + WS_MKV), 2048};
          pg8::gemm_phase<pg8::EpiBf, pg8::StaticOrder, true, true>(F.lds, g, S, E); }
    REPBAR(10); } SEAM(10);
    if (IN(11)) for (int rep = 0; rep < NREP(11); ++rep) {
        for (int u = F.vcu; u < 512; u += F.G) { const int bh = u >> 3, qb = u & 7;
            mla_unit(F.lds, (const bf16*)(ws + WS_MQ), (const bf16*)(ws + WS_MKV), (const bf16*)(ws + WS_KROPE), (bf16*)(ws + WS_MO), bh >> 3, bh & 7, qb); }
    REPBAR(11); } SEAM(11);
    if (IN(12)) for (int rep = 0; rep < NREP(12); ++rep) {
        pg8::Gemm g{(const bf16*)(ws + WS_MO), (const bf16*)(ws + WS_W_MOUT), T, 1024, 1024}; pg8::StaticOrder S; S.init(T, 1024, F.G, (int)blockIdx.x);
        pg8::EpiRes E{rep ? DUMH : P.H, rep ? DUMH : P.H, DN_ALPHA, ABL_MLA};
        pg8::gemm_phase<pg8::EpiRes, pg8::StaticOrder, true, true>(F.lds, g, S, E);
    REPBAR(12); } SEAM(12);
    if (IN(13)) for (int rep = 0; rep < NREP(13); ++rep) { ln_rows(F, P.H, rep ? DUMB : HB, P.ln_mix_g + DM, P.ln_mix_b + DM, STAT); REPBAR(13); } SEAM(13);
    if (IN(14)) for (int rep = 0; rep < NREP(14); ++rep) {
        pg8::Gemm g{HB, (const bf16*)(ws + WS_W_PQ) + (size_t)1024 * 2048, T, 2048, 1024}; pg8::StaticOrder S; S.init(T, 2048, F.G, (int)blockIdx.x);
        pg8::EpiBf E{(bf16*)(ws + WS_QP), 2048};
        pg8::gemm_phase<pg8::EpiBf, pg8::StaticOrder, true, true>(F.lds, g, S, E);
    REPBAR(14); } SEAM(14);
    if (IN(15)) for (int rep = 0; rep < NREP(15); ++rep) {
#ifdef TOPK_BRUTE
        for (int u = F.vcu; u < 256; u += F.G) topk_brute_unit(F.lds, (const bf16*)(ws + WS_QP), (const bf16*)(ws + WS_W_SK) + (size_t)8 * 2 * 128 * 128, SELI, SELG, u >> 3, u & 7);
#else
        for (int u = F.vcu, ui = 0; u < 512; u += F.G, ++ui) topk_unit(F.lds, (const bf16*)(ws + WS_QP), (const bf16*)(ws + WS_W_SK) + (size_t)8 * 2 * 128 * 128, SELI, SELG, u >> 3, u & 7);
#endif
    REPBAR(15); } SEAM(15);
    if (IN(16)) for (int rep = 0; rep < NREP(16); ++rep) { peer_gather<GV2>(F, rep ? DUMH : P.H, rep ? DUMB : HB, SELI, SELG, ws + WS_PU + (size_t)16384 * 1024, ws + WS_PV + (size_t)16384 * 1024, P.ln_ffn_g + DM, P.ln_ffn_b + DM, STAT, P.ln_mix_g + DM, P.ln_mix_b + DM); REPBAR(16); }
#undef IN
#undef SEAM
}

extern "C" void kernel_launch(void* const* d_in, const int* in_sizes, int n_in, void* d_out, int out_size, void* d_ws, size_t ws_size, hipStream_t stream) {
    static int grid = 0;
    if (grid == 0) {
        if (n_in != 21 || in_sizes[0] != T * DM || out_size != T * DM || ws_size < WS_END) { fprintf(stderr, "kernel_launch: unexpected shapes (n_in %d, in0 %d, out %d, ws %zu); nothing launched\n", n_in, n_in > 0 ? in_sizes[0] : -1, out_size, ws_size); grid = -1; return; }
        int dev = 0, cus = 0, per_cu = 0;
        if (hipGetDevice(&dev) != hipSuccess || hipDeviceGetAttribute(&cus, hipDeviceAttributeMultiprocessorCount, dev) != hipSuccess) { grid = -1; return; }
        if (hipFuncSetAttribute((const void*)mk_fwd, hipFuncAttributeMaxDynamicSharedMemorySize, LDS_BYTES) != hipSuccess) { fprintf(stderr, "kernel_launch: hipFuncSetAttribute failed\n"); grid = -1; return; }
        if (hipOccupancyMaxActiveBlocksPerMultiprocessor(&per_cu, (const void*)mk_fwd, NWAVES * 64, LDS_BYTES) != hipSuccess || per_cu < 1) { fprintf(stderr, "kernel_launch: occupancy query says %d blocks per CU\n", per_cu); }
        (void)hipGetLastError();
        grid = cus;
    }
    if (grid < 0) return;
    if (hipMemsetAsync((char*)d_ws + WS_CTL, 0, CTL_ZERO_BYTES, stream) != hipSuccess) return;
    Args a{};
    for (int i = 0; i < 21; ++i) a.in[i] = d_in[i];
    a.out = (float*)d_out; a.ws = (unsigned char*)d_ws;
#if MK_SINGLE
    a.ph_lo = 0; a.ph_hi = NPH;
    hipLaunchKernelGGL(mk_fwd, dim3(grid), dim3(NWAVES * 64), LDS_BYTES, stream, a);
#else
    for (int li = 0; li < NPH; ++li) { a.ph_lo = li; a.ph_hi = li + 1; hipLaunchKernelGGL(mk_fwd, dim3(grid), dim3(NWAVES * 64), LDS_BYTES, stream, a); }
#endif
}
```

```cpp
#include <hip/hip_runtime.h>
#include <cstdio>
#include <cstdint>
#include <cmath>
namespace pg8 {
#define PG8_LAS __attribute__((address_space(3)))
typedef unsigned short bf16_t;
typedef short bf16x8 __attribute__((ext_vector_type(8)));
typedef float f32x4 __attribute__((ext_vector_type(4)));
typedef unsigned u32x4 __attribute__((ext_vector_type(4)));
constexpr int BM = 256, BK = 64, HALF = 128, HTB = HALF * BK * 2  , STAGE_BYTES = 8 * HTB, NXCD = 8, WGM = 8;

__host__ __device__ __forceinline__ int lds_byte(int r, int c) { const int st = (r >> 4) * 2 + (c >> 5), rr = r & 15, cc = c & 31, ob = rr * 64 + cc * 2; return st * 1024 + (ob ^ (((ob >> 9) & 1) << 5)); }
__host__ __device__ __forceinline__ void stage_rc(int b, int& R, int& C) { const int st = b / 1024, sb = b % 1024, swz = sb ^ (((sb >> 9) & 1) << 5); R = (st >> 1) * 16 + swz / 64; C = (st & 1) * 32 + (swz % 64) / 2; }
__host__ __device__ __forceinline__ int perm32(int rho) { const int n = rho >> 4, i = rho & 15; return 8 * (i >> 2) + 4 * n + (i & 3); }

struct Unit { int pm, pn; };
struct Gemm { const bf16_t* A; const bf16_t* Bt; int M, N, K; };

struct StaticOrder {
    int nM, nN, nwg, G, c;
    __host__ __device__ void init(int M, int N, int G_, int c_) { nM = M / BM; nN = N / BM; nwg = nM * nN; G = G_; c = c_; }
    __host__ __device__ bool next(int i, Unit& u) const {
        const long L = (long)i * G + c; if (L >= nwg) return false;
        int wgid = (int)L; { const int q = nwg / NXCD, r = nwg % NXCD, xcd = wgid % NXCD, off = wgid / NXCD; wgid = (xcd < r ? xcd * (q + 1) : r * (q + 1) + (xcd - r) * q) + off; }
        const int nig = WGM * nN, gid = wgid / nig, fm = gid * WGM, gsz = (nM - fm) < WGM ? (nM - fm) : WGM;
        u.pm = fm + ((wgid % nig) % gsz); u.pn = (wgid % nig) / gsz; return true;
    }
    __device__ __forceinline__ void a_ready(const Unit&) const {}
    __device__ __forceinline__ void done(const Unit&) const {}
};

typedef float f32x2_cv __attribute__((ext_vector_type(2))); typedef __bf16 bf16x2_cv __attribute__((ext_vector_type(2)));
__device__ __forceinline__ unsigned cvt_pk_bf16(float lo, float hi) { f32x2_cv v = {lo, hi}; bf16x2_cv b = __builtin_convertvector(v, bf16x2_cv); return __builtin_bit_cast(unsigned, b); }
typedef float f32x2 __attribute__((ext_vector_type(2)));
__device__ __forceinline__ u32x4 pack8(const f32x4 a, const f32x4 b, float sc) {
    u32x4 w; w.x = cvt_pk_bf16(a[0] * sc, a[1] * sc); w.y = cvt_pk_bf16(a[2] * sc, a[3] * sc); w.z = cvt_pk_bf16(b[0] * sc, b[1] * sc); w.w = cvt_pk_bf16(b[2] * sc, b[3] * sc); return w;
}
struct EpiRetIn {
    static constexpr bool PERM = true, AFTER_DRAIN = false;
    bf16_t *Q, *Kb, *V, *G; const int* pos;
    __device__ __forceinline__ void operator()(const f32x4 (&acc)[2][2][4][2], const Unit& u, int wr, int wc, int fr, int fq) const {
        const int row0 = u.pm * BM + wr * 64 + fr;
        if (u.pn < 8) {
            bf16_t* base = (u.pn < 4) ? Q : Kb; const int head = u.pn & 3; const float sc = (u.pn < 4) ? 1.0f : 0.0625f;
            const int i0 = wc * 32 + 8 * fq;
            float fv[8];
#pragma unroll
            for (int j = 0; j < 8; ++j) fv[j] = __builtin_amdgcn_exp2f(-(float)(i0 + j) * (13.287712379549449f / 128.0f)) * 0.15915494309189535f;
#pragma unroll
            for (int ai = 0; ai < 2; ++ai)
#pragma unroll
                for (int m = 0; m < 4; ++m) {
                    const int row = row0 + ai * HALF + m * 16; const float p = (float)pos[row];
                    f32x4 o1[2], o2[2];
#pragma unroll
                    for (int n = 0; n < 2; ++n)
#pragma unroll
                        for (int e = 0; e < 4; ++e) {
                            float a = p * fv[4 * n + e]; a = __builtin_amdgcn_fractf(a);
                            const float s = __builtin_amdgcn_sinf(a), c = __builtin_amdgcn_cosf(a);
                            const float x1 = acc[ai][0][m][n][e], x2 = acc[ai][1][m][n][e];
                            o1[n][e] = x1 * c - x2 * s; o2[n][e] = x1 * s + x2 * c;
                        }
                    bf16_t* rp = base + (size_t)row * 1024 + head * 256 + i0;
                    *(u32x4*)rp = pack8(o1[0], o1[1], sc); *(u32x4*)(rp + 128) = pack8(o2[0], o2[1], sc);
                    asm volatile("" ::: "memory");
                }
        } else {
            bf16_t* base = (u.pn < 16) ? V : G; const int ct = (u.pn < 16) ? u.pn - 8 : u.pn - 16;
            const int col0 = ct * BM + wc * 32 + 8 * fq;
#pragma unroll
            for (int ai = 0; ai < 2; ++ai)
#pragma unroll
                for (int m = 0; m < 4; ++m) {
                    bf16_t* rp = base + (size_t)(row0 + ai * HALF + m * 16) * 2048 + col0;
#pragma unroll
                    for (int bj = 0; bj < 2; ++bj) *(u32x4*)(rp + bj * HALF) = pack8(acc[ai][bj][m][0], acc[ai][bj][m][1], 1.0f);
                }
        }
    }
};
struct EpiRes {
    static constexpr bool PERM = true, AFTER_DRAIN = false;
    const float* base; float* out; float alpha; float mixs;
    __device__ __forceinline__ void operator()(const f32x4 (&acc)[2][2][4][2], const Unit& u, int wr, int wc, int fr, int fq) const {
        const int row0 = u.pm * BM + wr * 64 + fr, col0 = u.pn * BM + wc * 32 + 8 * fq;
#pragma unroll
        for (int ai = 0; ai < 2; ++ai)
#pragma unroll
            for (int m = 0; m < 4; ++m) {
                const size_t off = (size_t)(row0 + ai * HALF + m * 16) * 1024 + col0;
#pragma unroll
                for (int bj = 0; bj < 2; ++bj)
#pragma unroll
                    for (int n = 0; n < 2; ++n) { const f32x4 b = *(const f32x4*)(base + off + bj * HALF + 4 * n); *(f32x4*)(out + off + bj * HALF + 4 * n) = b * alpha + acc[ai][bj][m][n] * mixs; }
            }
    }
};
struct EpiF32 {
    static constexpr bool PERM = true, AFTER_DRAIN = false;
    float* C; int ldc;
    __device__ __forceinline__ void operator()(const f32x4 (&acc)[2][2][4][2], const Unit& u, int wr, int wc, int fr, int fq) const {
        const int row0 = u.pm * BM + wr * 64 + fr, col0 = u.pn * BM + wc * 32 + 8 * fq;
#pragma unroll
        for (int ai = 0; ai < 2; ++ai)
#pragma unroll
            for (int m = 0; m < 4; ++m) {
                const size_t off = (size_t)(row0 + ai * HALF + m * 16) * ldc + col0;
#pragma unroll
                for (int bj = 0; bj < 2; ++bj)
#pragma unroll
                    for (int n = 0; n < 2; ++n) *(f32x4*)(C + off + bj * HALF + 4 * n) = acc[ai][bj][m][n];
            }
    }
};
struct EpiBf {
    static constexpr bool PERM = true, AFTER_DRAIN = false;
    bf16_t* O; int ldc;
    __device__ __forceinline__ void operator()(const f32x4 (&acc)[2][2][4][2], const Unit& u, int wr, int wc, int fr, int fq) const {
        const int row0 = u.pm * BM + wr * 64 + fr, col0 = u.pn * BM + wc * 32 + 8 * fq;
#pragma unroll
        for (int ai = 0; ai < 2; ++ai)
#pragma unroll
            for (int m = 0; m < 4; ++m) {
                bf16_t* rp = O + (size_t)(row0 + ai * HALF + m * 16) * ldc + col0;
#pragma unroll
                for (int bj = 0; bj < 2; ++bj) *(u32x4*)(rp + bj * HALF) = pack8(acc[ai][bj][m][0], acc[ai][bj][m][1], 1.0f);
            }
    }
};
struct EpiUq {
    static constexpr bool PERM = true, AFTER_DRAIN = false;
    bf16_t* O; const int* pos; float qs;
    __device__ __forceinline__ void operator()(const f32x4 (&acc)[2][2][4][2], const Unit& u, int wr, int wc, int fr, int fq) const {
        const int row0 = u.pm * BM + wr * 64 + fr, col0 = u.pn * BM + wc * 32 + 8 * fq;
        if (u.pn < 4) {
#pragma unroll
            for (int ai = 0; ai < 2; ++ai)
#pragma unroll
                for (int m = 0; m < 4; ++m) {
                    bf16_t* rp = O + (size_t)(row0 + ai * HALF + m * 16) * 1536 + col0;
#pragma unroll
                    for (int bj = 0; bj < 2; ++bj) *(u32x4*)(rp + bj * HALF) = pack8(acc[ai][bj][m][0], acc[ai][bj][m][1], qs);
                }
        } else {
            float fv[8];
#pragma unroll
            for (int j = 0; j < 8; ++j) fv[j] = __builtin_amdgcn_exp2f(-(float)(8 * fq + j) * (13.287712379549449f / 32.0f)) * 0.15915494309189535f;
#pragma unroll
            for (int ai = 0; ai < 2; ++ai)
#pragma unroll
                for (int m = 0; m < 4; ++m) {
                    const int row = row0 + ai * HALF + m * 16; const float p = (float)pos[row];
                    f32x4 o1[2], o2[2];
#pragma unroll
                    for (int n = 0; n < 2; ++n)
#pragma unroll
                        for (int e = 0; e < 4; ++e) {
                            float a = p * fv[4 * n + e]; a = __builtin_amdgcn_fractf(a);
                            const float s = __builtin_amdgcn_sinf(a), c = __builtin_amdgcn_cosf(a);
                            const float x1 = acc[ai][0][m][n][e], x2 = acc[ai][1][m][n][e];
                            o1[n][e] = x1 * c - x2 * s; o2[n][e] = x1 * s + x2 * c;
                        }
                    bf16_t* rp = O + (size_t)row * 1536 + col0;
                    *(u32x4*)rp = pack8(o1[0], o1[1], qs); *(u32x4*)(rp + 128) = pack8(o2[0], o2[1], qs);
                    asm volatile("" ::: "memory");
                }
        }
    }
};
template <class Epi, class Sched, bool ALIGN_EPI = false, bool SP2 = false>
__device__ __forceinline__ void gemm_phase(PG8_LAS unsigned char* lds, const Gemm g, const Sched& S, const Epi& E) {
    const int tid = threadIdx.x, wid = __builtin_amdgcn_readfirstlane(tid >> 6), lane = tid & 63, wr = wid >> 2, wc = wid & 3, fr = lane & 15, fq = lane >> 4;
    const int K = g.K, nt = K / BK;
    unsigned voffA[2], voffB[2];
#pragma unroll
    for (int i = 0; i < 2; ++i) { int R, C; stage_rc(tid * 16 + i * 8192, R, C); const int Rb = Epi::PERM ? ((R & ~31) + perm32(R & 31)) : R;
        voffA[i] = (unsigned)(R * K + C) * 2u; voffB[i] = (unsigned)(Rb * K + C) * 2u; }
    const size_t kstep = (size_t)(BK * 2);
    const size_t hstep = (size_t)HALF * K * 2;
    const size_t tstep = 2 * hstep;
    const unsigned ldsw = (unsigned)wid * 1024u;
    const int aoff = lds_byte(wr * 64 + fr, fq * 8), boff = lds_byte(wc * 32 + fr, fq * 8);
#define PG8_SA(b, h) (((b) * 2 + (h)) * HTB)
#define PG8_SB(b, h) ((4 + (b) * 2 + (h)) * HTB)
#define PG8_STAGE(bufoff, gbase, voff) do { _Pragma("unroll") for (int _i = 0; _i < 2; ++_i) \
        __builtin_amdgcn_global_load_lds((const unsigned*)((const char*)(gbase) + (voff)[_i]), (PG8_LAS unsigned*)(lds + (bufoff) + ldsw + _i * 8192), 16, 0, 0); } while (0)
#define PG8_LDA(dst, b, h) do { _Pragma("unroll") for (int m = 0; m < 4; ++m) _Pragma("unroll") for (int k = 0; k < 2; ++k) dst[m][k] = *(const PG8_LAS bf16x8*)(lds + PG8_SA(b, h) + aoff + m * 2048 + k * 1024); } while (0)
#define PG8_LDB(dst, b, h) do { _Pragma("unroll") for (int n = 0; n < 2; ++n) _Pragma("unroll") for (int k = 0; k < 2; ++k) dst[n][k] = *(const PG8_LAS bf16x8*)(lds + PG8_SB(b, h) + boff + n * 2048 + k * 1024); } while (0)
#define PG8_MMA(ai, bj, At, Bt) do { __builtin_amdgcn_s_setprio(1); _Pragma("unroll") for (int m = 0; m < 4; ++m) _Pragma("unroll") for (int n = 0; n < 2; ++n) _Pragma("unroll") for (int k = 0; k < 2; ++k) \
        acc[ai][bj][m][n] = __builtin_amdgcn_mfma_f32_16x16x32_bf16(Bt[n][k], At[m][k], acc[ai][bj][m][n], 0, 0, 0); __builtin_amdgcn_s_setprio(0); } while (0)
#define PG8_WAIT_V(n) asm volatile("s_waitcnt vmcnt(" #n ")" ::: "memory")
#define PG8_WAIT_L(n) asm volatile("s_waitcnt lgkmcnt(" #n ")" ::: "memory")
#define PG8_BAR __builtin_amdgcn_s_barrier()
#define PG8_SCHED __builtin_amdgcn_sched_barrier(0)
    Unit cur, nxt; int ui = 0;
    if (!S.next(0, cur)) return;
    f32x4 acc[2][2][4][2];
#pragma unroll
    for (int a = 0; a < 2; ++a)
#pragma unroll
        for (int b = 0; b < 2; ++b)
#pragma unroll
            for (int m = 0; m < 4; ++m)
#pragma unroll
                for (int n = 0; n < 2; ++n) acc[a][b][m][n] = (f32x4){0.f, 0.f, 0.f, 0.f};
    bf16x8 At[4][2], B0[2][2], B1[2][2];
    const char* cA = (const char*)g.A + (size_t)cur.pm * tstep; const char* cB = (const char*)g.Bt + (size_t)cur.pn * tstep;
    S.a_ready(cur);
    if constexpr (SP2) {
        PG8_STAGE(PG8_SB(0, 0), cB, voffB); PG8_STAGE(PG8_SB(0, 1), cB + hstep, voffB); PG8_STAGE(PG8_SA(0, 0), cA, voffA); PG8_STAGE(PG8_SA(0, 1), cA + hstep, voffA);
        if (wr == 1) PG8_BAR;
        PG8_WAIT_V(2); PG8_BAR;
        PG8_STAGE(PG8_SB(1, 0), cB + kstep, voffB); PG8_STAGE(PG8_SA(1, 0), cA + kstep, voffA); PG8_STAGE(PG8_SB(1, 1), cB + hstep + kstep, voffB);
        PG8_WAIT_V(6); PG8_BAR;
    } else {
        PG8_STAGE(PG8_SB(0, 0), cB, voffB); PG8_STAGE(PG8_SA(0, 0), cA, voffA); PG8_STAGE(PG8_SB(0, 1), cB + hstep, voffB); PG8_STAGE(PG8_SA(0, 1), cA + hstep, voffA);
        if (wr == 1) PG8_BAR;
        PG8_WAIT_V(4); PG8_BAR;
        PG8_STAGE(PG8_SB(1, 0), cB + kstep, voffB); PG8_STAGE(PG8_SA(1, 0), cA + kstep, voffA); PG8_STAGE(PG8_SB(1, 1), cB + hstep + kstep, voffB);
        PG8_WAIT_V(6); PG8_BAR;
    }
    for (;;) {
        const bool has_next = S.next(ui + 1, nxt);
        const char* nA = has_next ? (const char*)g.A + (size_t)nxt.pm * tstep : cA; const char* nB = has_next ? (const char*)g.Bt + (size_t)nxt.pn * tstep : cB;
#pragma unroll 1
        for (int t = 0; t < nt; t += 2) {
            const bool last = (t == nt - 2);
            const char* a1 = cA + (size_t)(t + 1) * kstep;
            const char* a2 = last ? nA : cA + (size_t)(t + 2) * kstep; const char* b2 = last ? nB : cB + (size_t)(t + 2) * kstep;
            const char* a3 = a2 + kstep; const char* b3 = b2 + kstep;
            if (last && has_next) S.a_ready(nxt);
            if constexpr (SP2) {
            PG8_LDB(B0, 0, 0); PG8_LDB(B1, 0, 1); PG8_SCHED; PG8_LDA(At, 0, 0); PG8_STAGE(PG8_SA(1, 1), a1 + hstep, voffA);
            PG8_WAIT_V(8); PG8_WAIT_L(0); PG8_BAR; PG8_MMA(0, 0, At, B0); PG8_MMA(0, 1, At, B1); PG8_BAR; PG8_SCHED;
            PG8_LDA(At, 0, 1); PG8_STAGE(PG8_SB(0, 0), b2, voffB); PG8_STAGE(PG8_SB(0, 1), b2 + hstep, voffB); PG8_STAGE(PG8_SA(0, 0), a2, voffA);
            PG8_WAIT_V(8); PG8_WAIT_L(0); PG8_BAR; PG8_MMA(1, 0, At, B0); PG8_MMA(1, 1, At, B1); PG8_BAR; PG8_SCHED;
            PG8_LDB(B0, 1, 0); PG8_LDB(B1, 1, 1); PG8_SCHED; PG8_LDA(At, 1, 0); PG8_STAGE(PG8_SA(0, 1), a2 + hstep, voffA);
            PG8_WAIT_V(8); PG8_WAIT_L(0); PG8_BAR; PG8_MMA(0, 0, At, B0); PG8_MMA(0, 1, At, B1); PG8_BAR; PG8_SCHED;
            PG8_LDA(At, 1, 1); PG8_STAGE(PG8_SB(1, 0), b3, voffB); PG8_STAGE(PG8_SB(1, 1), b3 + hstep, voffB); PG8_STAGE(PG8_SA(1, 0), a3, voffA);
            PG8_WAIT_V(8); PG8_WAIT_L(0); PG8_BAR; PG8_MMA(1, 0, At, B0); PG8_MMA(1, 1, At, B1); PG8_BAR; PG8_SCHED;
            } else {
            PG8_LDB(B0, 0, 0); PG8_SCHED; PG8_LDA(At, 0, 0); PG8_STAGE(PG8_SA(1, 1), a1 + hstep, voffA);
            PG8_WAIT_L(8); PG8_BAR; PG8_WAIT_L(0); PG8_MMA(0, 0, At, B0); PG8_BAR; PG8_SCHED;
            PG8_LDB(B1, 0, 1); PG8_STAGE(PG8_SB(0, 0), b2, voffB);
            PG8_BAR; PG8_WAIT_L(0); PG8_MMA(0, 1, At, B1); PG8_BAR;
            PG8_LDA(At, 0, 1); PG8_STAGE(PG8_SA(0, 0), a2, voffA);
            PG8_BAR; PG8_WAIT_L(0); PG8_MMA(1, 0, At, B0); PG8_BAR; PG8_SCHED;
            PG8_STAGE(PG8_SB(0, 1), b2 + hstep, voffB);
            PG8_WAIT_V(6); PG8_BAR; PG8_MMA(1, 1, At, B1); PG8_BAR;
            PG8_LDB(B0, 1, 0); PG8_SCHED; PG8_LDA(At, 1, 0); PG8_STAGE(PG8_SA(0, 1), a2 + hstep, voffA);
            PG8_WAIT_L(8); PG8_BAR; PG8_WAIT_L(0); PG8_MMA(0, 0, At, B0); PG8_BAR; PG8_SCHED;
            PG8_LDB(B1, 1, 1); PG8_STAGE(PG8_SB(1, 0), b3, voffB);
            PG8_BAR; PG8_WAIT_L(0); PG8_MMA(0, 1, At, B1); PG8_BAR;
            PG8_LDA(At, 1, 1); PG8_STAGE(PG8_SA(1, 0), a3, voffA);
            PG8_BAR; PG8_WAIT_L(0); PG8_MMA(1, 0, At, B0); PG8_BAR; PG8_SCHED;
            PG8_STAGE(PG8_SB(1, 1), b3 + hstep, voffB);
            PG8_WAIT_V(6); PG8_BAR; PG8_MMA(1, 1, At, B1); PG8_BAR;
            }
        }
        if constexpr (ALIGN_EPI) { if (wr == 0) PG8_BAR; }
        if constexpr (!Epi::AFTER_DRAIN) { E(acc, cur, wr, wc, fr, fq); S.done(cur); }
        if (!has_next) break;
#pragma unroll
        for (int a = 0; a < 2; ++a)
#pragma unroll
            for (int b = 0; b < 2; ++b)
#pragma unroll
                for (int m = 0; m < 4; ++m)
#pragma unroll
                    for (int n = 0; n < 2; ++n) acc[a][b][m][n] = (f32x4){0.f, 0.f, 0.f, 0.f};
        cur = nxt; cA = nA; cB = nB; ++ui;
        if constexpr (ALIGN_EPI) { if (wr == 1) PG8_BAR; }
    }
    PG8_WAIT_V(0);
    if constexpr (!ALIGN_EPI) { if (wr == 0) PG8_BAR; }
    PG8_BAR;
    if constexpr (Epi::AFTER_DRAIN) { E.fused(acc, cur, wr, wc, fr, fq, lds, wid, lane); S.done(cur); }
#undef PG8_SA
#undef PG8_SB
#undef PG8_STAGE
#undef PG8_LDA
#undef PG8_LDB
#undef PG8_MMA
#undef PG8_WAIT_V
#undef PG8_WAIT_L
#undef PG8_BAR
#undef PG8_SCHED
}
}
#define GAS __attribute__((address_space(1)))
#define LAS __attribute__((address_space(3)))
typedef unsigned short bf16;
typedef unsigned v4u __attribute__((ext_vector_type(4)));
typedef float f32x4 __attribute__((ext_vector_type(4)));
typedef short bf16x8 __attribute__((ext_vector_type(8)));
typedef GAS unsigned gu32;
typedef GAS unsigned long long gu64;
#define RLX_AGENT __ATOMIC_RELAXED, __HIP_MEMORY_SCOPE_AGENT
#define LDS_WAIT() asm volatile("s_waitcnt lgkmcnt(0)" ::: "memory")
#define VM_WAIT() asm volatile("s_waitcnt vmcnt(0)" ::: "memory")
__device__ __forceinline__ unsigned long long rt() { return __builtin_amdgcn_s_memrealtime(); }
__device__ __forceinline__ unsigned f2bf(float f) { unsigned u = __builtin_bit_cast(unsigned, f); return (u + 0x7fffu + ((u >> 16) & 1u)) >> 16; }
__device__ __forceinline__ unsigned pk2(float lo, float hi) { return f2bf(lo) | (f2bf(hi) << 16); }
#define XB_TMO      128
#define XB_XCNT(j)  (256  + 64 * (j))
#define XB_XSUB(j)  (1280 + 64 * (j))
#define XB_XGEN(j)  (2304 + 64 * (j))
#define XB_TOP      3328
#define XB_TOPGEN   3392
#define XCD_BAR_WORDS 3456
#define XB_SPIN_CAP (1u << 18)

__device__ __forceinline__ unsigned xb_ld(unsigned* p)              { return __hip_atomic_load(p, __ATOMIC_RELAXED, __HIP_MEMORY_SCOPE_AGENT); }
__device__ __forceinline__ unsigned xb_add(unsigned* p, unsigned v) { return __hip_atomic_fetch_add(p, v, __ATOMIC_RELAXED, __HIP_MEMORY_SCOPE_AGENT); }
__device__ __forceinline__ unsigned xb_xcc_id() { return (unsigned)__builtin_amdgcn_s_getreg((3 << 11) | 20) & 0xFu; }
#define XB_SPIN(cond, bar) do { unsigned _sp = 0; while (cond) { __builtin_amdgcn_s_sleep(1); \
    if ((++_sp & 255u) == 0u) { if (xb_ld(&(bar)[XB_TMO])) break; if (_sp > XB_SPIN_CAP) { atomicAdd(&(bar)[XB_TMO], 1u); break; } } } } while (0)

struct XcdBarrier {
    unsigned* bar; unsigned x;
    volatile LAS unsigned* st;
};

__device__ __forceinline__ XcdBarrier xcd_barrier_post(unsigned* bar, volatile LAS unsigned* st) {
    XcdBarrier b; b.bar = bar; b.x = xb_xcc_id(); b.st = st;
    if (threadIdx.x == 0) (void)xb_add(&bar[XB_XCNT(b.x)], 1u);
    return b;
}
__device__ __forceinline__ void xcd_barrier_complete(unsigned* bar, unsigned x, unsigned& nloc, unsigned& nx) {
    const unsigned G = gridDim.x * gridDim.y * gridDim.z;
    unsigned sum, cnt, mine, sp = 0u;
    for (;;) {
        sum = 0u; cnt = 0u; mine = 0u;
#pragma unroll
        for (unsigned j = 0; j < 16; ++j) { const unsigned c = xb_ld(&bar[XB_XCNT(j)]); sum += c; cnt += (c > 0u) ? 1u : 0u; mine = (j == x) ? c : mine; }
        if (sum == G) break;
        __builtin_amdgcn_s_sleep(1);
        if ((++sp & 255u) == 0u) { if (xb_ld(&bar[XB_TMO])) break; if (sp > XB_SPIN_CAP) { atomicAdd(&bar[XB_TMO], 1u); break; } }
    }
    nloc = mine > 0u ? mine : 1u; nx = cnt > 0u ? cnt : 1u;
}

__device__ __forceinline__ void xcd_barrier(const XcdBarrier& b) {
    asm volatile("s_waitcnt vmcnt(0)" ::: "memory");
    __syncthreads();
    if (threadIdx.x == 0) {
        unsigned* bar = b.bar;
        __builtin_amdgcn_s_waitcnt(0);
        unsigned nloc = b.st[0], nx = b.st[1];
        if (nloc == 0u) { xcd_barrier_complete(bar, b.x, nloc, nx); b.st[0] = nloc; b.st[1] = nx; }
        const unsigned old = xb_add(&bar[XB_XSUB(b.x)], 1u);
        const unsigned gen = old / nloc;
        if (old + 1u == (gen + 1u) * nloc) {
            __builtin_amdgcn_fence(__ATOMIC_RELEASE, "agent");
            asm volatile("s_waitcnt vmcnt(0)" ::: "memory");
            const unsigned og = xb_add(&bar[XB_TOP], 1u);
            const unsigned tg = og / nx;
            if (og + 1u == (tg + 1u) * nx) xb_add(&bar[XB_TOPGEN], 1u);
            else XB_SPIN(xb_ld(&bar[XB_TOPGEN]) == tg, bar);
            __builtin_amdgcn_fence(__ATOMIC_ACQUIRE, "agent");
            xb_add(&bar[XB_XGEN(b.x)], 1u);
            asm volatile("s_waitcnt vmcnt(0)" ::: "memory");
        } else {
            XB_SPIN(xb_ld(&bar[XB_XGEN(b.x)]) == gen, bar);
            __builtin_amdgcn_fence(__ATOMIC_ACQUIRE, "agent");
            asm volatile("s_waitcnt vmcnt(0)" ::: "memory");
        }
    }
    __syncthreads();
}
constexpr int NWAVES = 8;
constexpr int BATCH = 8, SEQ = 2048, DM = 1024, T = BATCH * SEQ;
constexpr float LN_EPS = 1e-5f, DN_ALPHA = 1.4142135623730951f;
constexpr float MLA_QS = 0.07216878364870322f * 1.4426950408889634f;
constexpr size_t MiB = 1u << 20;
constexpr size_t WS_CTL = 0, CTL_ZERO_BYTES = 1 * MiB;
constexpr size_t WS_W_RIN = 1 * MiB, WS_W_ROUT = 13 * MiB, WS_W_MIN = 17 * MiB, WS_W_UQ = 19 * MiB, WS_W_UKV = 21 * MiB, WS_W_MOUT = 22 * MiB, WS_W_PQ = 24 * MiB, WS_W_SK = 32 * MiB;
constexpr size_t WS_PU = 33 * MiB, WS_PV = 97 * MiB, WS_HB = 161 * MiB, WS_SELI = 193 * MiB, WS_SELG = 201 * MiB;
constexpr size_t WS_ACT = 209 * MiB;
constexpr size_t WS_RQ = WS_ACT, WS_RK = WS_ACT + 32 * MiB, WS_RV = WS_ACT + 64 * MiB, WS_RG = WS_ACT + 128 * MiB;
constexpr size_t WS_QP = WS_ACT;
constexpr size_t WS_MC = WS_ACT, WS_CQN = WS_ACT + 48 * MiB, WS_CKVN = WS_ACT + 60 * MiB, WS_KROPE = WS_ACT + 68 * MiB, WS_MQ = WS_ACT + 70 * MiB, WS_MKV = WS_ACT + 118 * MiB, WS_MO = WS_ACT + 182 * MiB;
constexpr size_t WS_END = WS_ACT + 214 * MiB;
constexpr int CW_BAR = 4096;
constexpr int RING_BYTES = 131072, LDSCTL_OFF = RING_BYTES, MISC_OFF = LDSCTL_OFF + 320, LDS_BYTES = 163840;

__device__ __forceinline__ float bf2f(bf16 v) { return __builtin_bit_cast(float, (unsigned)v << 16); }
__device__ __forceinline__ float wave_sum(float v) {
#pragma unroll
    for (int o = 1; o < 64; o <<= 1) v += __shfl_xor(v, o);
    return v;
}
__device__ __forceinline__ float vmaxf(float a, float b) { return __builtin_fmaxf(a, b); }
__device__ __forceinline__ float vminf(float a, float b) { return __builtin_fminf(a, b); }
typedef float f32x16 __attribute__((ext_vector_type(16)));
typedef short s16x4 __attribute__((ext_vector_type(4)));
__device__ __forceinline__ int crow0(int r) { return (r & 3) + 8 * (r >> 2); }
__device__ __forceinline__ s16x4 vtr(const LAS unsigned char* p) { return __builtin_bit_cast(s16x4, __builtin_amdgcn_ds_read_tr16_b64_v4i16((LAS s16x4*)p)); }

struct Frame {
    LAS unsigned char* lds;
    int tid, lane, wave, vcu, G;
};

template <int NMAP>
__device__ __forceinline__ void p0_transpose_item(const float* W, int K, int N, bf16* WT, LAS float* scr, int item, int lane) {
    const int nblk = N / 32, kb = item / nblk, nb = item % nblk, k0 = 64 * kb, n0 = 32 * nb;
    int no = n0;
    if (NMAP == 1) { const int h = n0 / 192, d0 = n0 % 192; no = (d0 < 128) ? (h * 128 + d0) : (1024 + 256 * (h >> 2) + (h & 3) * 32 + (d0 == 160 ? 128 : 0)); }
#pragma unroll 8
    for (int i = 0; i < 32; ++i) { const int kk = 2 * i + (lane >> 5); scr[kk * 33 + (lane & 31)] = W[(size_t)(k0 + kk) * N + n0 + (lane & 31)]; }
    LDS_WAIT(); asm volatile("" ::: "memory");
    const int c = lane & 7;
#pragma unroll
    for (int j = 0; j < 4; ++j) { const int n = (lane >> 3) + 8 * j; const LAS float* s = scr + (8 * c) * 33 + n;
        v4u o; o.x = pk2(s[0 * 33], s[1 * 33]); o.y = pk2(s[2 * 33], s[3 * 33]); o.z = pk2(s[4 * 33], s[5 * 33]); o.w = pk2(s[6 * 33], s[7 * 33]);
        *(GAS v4u*)(WT + (size_t)(no + n) * K + k0 + 8 * c) = o; }
    LDS_WAIT(); asm volatile("" ::: "memory");
}
__device__ __forceinline__ void cvt_range(const float* src, bf16* dst, size_t n, int gw, int NGW, int lane) {
    const size_t nchunk = n / 2048;
    for (size_t c = gw; c < nchunk; c += NGW) {
        const float* s = src + c * 2048 + lane * 8; bf16* d = dst + c * 2048 + lane * 8;
        f32x4 a[4], b[4];
#pragma unroll
        for (int j = 0; j < 4; ++j) { a[j] = *(const GAS f32x4*)(s + j * 512); b[j] = *(const GAS f32x4*)(s + j * 512 + 4); }
#pragma unroll
        for (int j = 0; j < 4; ++j) { v4u o; o.x = pk2(a[j][0], a[j][1]); o.y = pk2(a[j][2], a[j][3]); o.z = pk2(b[j][0], b[j][1]); o.w = pk2(b[j][2], b[j][3]); *(GAS v4u*)(d + j * 512) = o; }
    }
}
__device__ __forceinline__ void cvt_range_fp8(const float* src, unsigned char* dst, size_t n, float scale, int gw, int NGW, int lane) {
    const size_t nchunk = n / 4096;
    for (size_t c = gw; c < nchunk; c += NGW) {
        f32x4 a[16];
#pragma unroll
        for (int j = 0; j < 16; ++j) a[j] = *(const GAS f32x4*)(src + c * 4096 + j * 256 + lane * 4);
#pragma unroll
        for (int j = 0; j < 16; ++j) { unsigned w = __builtin_amdgcn_cvt_pk_fp8_f32(a[j][0] * scale, a[j][1] * scale, 0, false); w = __builtin_amdgcn_cvt_pk_fp8_f32(a[j][2] * scale, a[j][3] * scale, w, true);
            *(GAS unsigned*)(dst + c * 4096 + j * 256 + lane * 4) = w; }
    }
}
struct Ptrs {
    const float *x; const int* pos;
    const float *ret_w_in, *ret_decay, *ret_gn_g, *ret_gn_b, *ret_w_out, *mla_w_in, *mla_qn, *mla_kvn, *mla_w_uq, *mla_w_ukv, *mla_w_out, *peer_w_q, *peer_sk, *peer_u, *peer_v, *ln_mix_g, *ln_mix_b, *ln_ffn_g, *ln_ffn_b;
    float* H; unsigned char* ws;
};
__device__ __forceinline__ void p0_prologue(const Frame& F, const Ptrs& P) {
    LAS float* scr = (LAS float*)(F.lds + F.wave * 16384);
    const int gw = F.vcu * NWAVES + F.wave, NGW = F.G * NWAVES;
    unsigned char* ws = P.ws;
    constexpr int I0 = 16 * 192, I1 = 32 * 32, I2 = 16 * 22, I3 = 6 * 48, I4 = 4 * 64, I5 = 16 * 32, I6 = 16 * 64;
    constexpr int NITEMS = I0 + I1 + I2 + I3 + I4 + I5 + 2 * I6;
    for (int it = gw; it < NITEMS; it += NGW) {
        int r = it;
        if (r < I0) { p0_transpose_item<0>(P.ret_w_in, 1024, 6144, (bf16*)(ws + WS_W_RIN), scr, r, F.lane); continue; } r -= I0;
        if (r < I1) { p0_transpose_item<0>(P.ret_w_out, 2048, 1024, (bf16*)(ws + WS_W_ROUT), scr, r, F.lane); continue; } r -= I1;
        if (r < I2) { p0_transpose_item<0>(P.mla_w_in, 1024, 704, (bf16*)(ws + WS_W_MIN), scr, r, F.lane); continue; } r -= I2;
        if (r < I3) { p0_transpose_item<1>(P.mla_w_uq, 384, 1536, (bf16*)(ws + WS_W_UQ), scr, r, F.lane); continue; } r -= I3;
        if (r < I4) { p0_transpose_item<0>(P.mla_w_ukv, 256, 2048, (bf16*)(ws + WS_W_UKV), scr, r, F.lane); continue; } r -= I4;
        if (r < I5) { p0_transpose_item<0>(P.mla_w_out, 1024, 1024, (bf16*)(ws + WS_W_MOUT), scr, r, F.lane); continue; } r -= I5;
        if (r < I6) { p0_transpose_item<0>(P.peer_w_q, 1024, 2048, (bf16*)(ws + WS_W_PQ), scr, r, F.lane); continue; } r -= I6;
        p0_transpose_item<0>(P.peer_w_q + (size_t)1024 * 2048, 1024, 2048, (bf16*)(ws + WS_W_PQ) + (size_t)1024 * 2048, scr, r, F.lane);
    }
    for (int c = gw; c < 32; c += NGW) { GAS v4u* d = (GAS v4u*)((bf16*)(ws + WS_W_MIN) + (size_t)704 * 1024 + c * 2048) + F.lane * 4;
#pragma unroll
        for (int j = 0; j < 4; ++j) d[j] = (v4u){0u, 0u, 0u, 0u}; }
    cvt_range(P.peer_sk, (bf16*)(ws + WS_W_SK), (size_t)2 * 8 * 2 * 128 * 128, gw, NGW, F.lane);
    cvt_range(P.x, (bf16*)(ws + WS_HB), (size_t)T * DM, gw, NGW, F.lane);
}

__device__ __forceinline__ void ln_rows(const Frame& F, const float* H, bf16* HB, const float* g, const float* b, float* STAT) {
    const int gw = F.vcu * NWAVES + F.wave, NGW = F.G * NWAVES;
    f32x4 gv[4], bv[4];
#pragma unroll
    for (int j = 0; j < 4; ++j) { gv[j] = *(const GAS f32x4*)(g + 4 * F.lane + 256 * j); bv[j] = *(const GAS f32x4*)(b + 4 * F.lane + 256 * j); }
    for (int m = gw; m < T; m += NGW) {
        const GAS f32x4* xr = (const GAS f32x4*)(H + (size_t)m * DM) + F.lane;
        f32x4 v[4]; float s = 0.f;
#pragma unroll
        for (int j = 0; j < 4; ++j) { v[j] = xr[64 * j]; s += (v[j].x + v[j].y) + (v[j].z + v[j].w); }
        const float mean = wave_sum(s) * (1.f / DM); float s2 = 0.f;
#pragma unroll
        for (int j = 0; j < 4; ++j) { v[j] = v[j] - mean; s2 += (v[j].x * v[j].x + v[j].y * v[j].y) + (v[j].z * v[j].z + v[j].w * v[j].w); }
        const float rstd = 1.f / sqrtf(wave_sum(s2) * (1.f / DM) + LN_EPS);
        GAS unsigned long long* o8 = (GAS unsigned long long*)(HB + (size_t)m * DM) + F.lane;
        if (F.lane == 0) { STAT[2 * (size_t)m] = mean; STAT[2 * (size_t)m + 1] = rstd; }
#pragma unroll
        for (int j = 0; j < 4; ++j) { const f32x4 y = v[j] * rstd * gv[j] + bv[j];
            o8[64 * j] = (unsigned long long)pk2(y.x, y.y) | ((unsigned long long)pk2(y.z, y.w) << 32); }
    }
}
__device__ __forceinline__ void mla_rows(const Frame& F, const Ptrs& P) {
    const int gw = F.vcu * NWAVES + F.wave, NGW = F.G * NWAVES, lane = F.lane;
    const float* C = (const float*)(P.ws + WS_MC); bf16* cqn = (bf16*)(P.ws + WS_CQN); bf16* ckvn = (bf16*)(P.ws + WS_CKVN); bf16* kr = (bf16*)(P.ws + WS_KROPE);
    float gq[6], gk[4];
#pragma unroll
    for (int j = 0; j < 6; ++j) gq[j] = P.mla_qn[lane + 64 * j];
#pragma unroll
    for (int j = 0; j < 4; ++j) gk[j] = P.mla_kvn[lane + 64 * j];
    const float fv = __builtin_amdgcn_exp2f(-(float)(lane & 31) * (13.287712379549449f / 32.0f)) * 0.15915494309189535f;
    for (int t = gw; t < T; t += NGW) {
        const float* c = C + (size_t)t * 768;
        float a[6], k[4]; float s = 0.f, s2 = 0.f;
#pragma unroll
        for (int j = 0; j < 6; ++j) { a[j] = c[lane + 64 * j]; s += a[j] * a[j]; }
#pragma unroll
        for (int j = 0; j < 4; ++j) { k[j] = c[384 + lane + 64 * j]; s2 += k[j] * k[j]; }
        const float v = c[640 + lane];
        const float rq = 1.f / sqrtf(wave_sum(s) * (1.f / 384.f) + LN_EPS), rk = 1.f / sqrtf(wave_sum(s2) * (1.f / 256.f) + LN_EPS);
#pragma unroll
        for (int j = 0; j < 6; ++j) cqn[(size_t)t * 384 + lane + 64 * j] = (bf16)f2bf(a[j] * rq * gq[j]);
#pragma unroll
        for (int j = 0; j < 4; ++j) ckvn[(size_t)t * 256 + lane + 64 * j] = (bf16)f2bf(k[j] * rk * gk[j]);
        const float pv = __shfl_xor(v, 32);
        float ang = (float)P.pos[t] * fv; ang = __builtin_amdgcn_fractf(ang);
        const float sn = __builtin_amdgcn_sinf(ang), cs = __builtin_amdgcn_cosf(ang);
        const float o = (lane < 32) ? (v * cs - pv * sn) : (pv * sn + v * cs);
        kr[(size_t)t * 64 + lane] = (bf16)f2bf(o);
    }
}

__device__ __forceinline__ const float* cv_src(const float* U, const float* V, int gp, int tid) { const int ch = (gp & 16383) >> 1;
    return ((ch < 4096) ? U + (size_t)ch * 4096 : V + (size_t)(ch - 4096) * 4096) + (size_t)(gp >> 14) * 16384 * 1024 + 2048 * (gp & 1) + 4 * tid; }
__device__ __forceinline__ unsigned char* cv_dst(unsigned char* U, int gp, int tid) { const int ch = (gp & 16383) >> 1;
    return U + (size_t)ch * 4096 + ((ch < 4096) ? (size_t)0 : (size_t)(WS_PV - WS_PU) - (size_t)4096 * 4096) + (size_t)(gp >> 14) * 16384 * 1024 + 2048 * (gp & 1) + 4 * tid; }
__device__ __forceinline__ void cv_store(unsigned char* d, const f32x4 v) { const float f0 = v[0], f1 = v[1], f2 = v[2], f3 = v[3];
    unsigned w = __builtin_amdgcn_cvt_pk_fp8_f32(f0 * 256.0f, f1 * 256.0f, 0, false); w = __builtin_amdgcn_cvt_pk_fp8_f32(f2 * 256.0f, f3 * 256.0f, w, true); *(GAS unsigned*)d = w; }

__device__ __forceinline__ void ret_unit(LAS unsigned char* lds, const bf16* __restrict__ Qg, const bf16* __restrict__ Kg, const bf16* __restrict__ Vg, bf16* Gz,
                                         const float* gng, const float* gnb, float lf, float lb, int b, int h, int qb,
                                         const float* cvU, const float* cvV, unsigned char* cdU, int cvu) {
    int tid = threadIdx.x; asm volatile("" : "+v"(tid));
    const int lane = tid & 63, wid = __builtin_amdgcn_readfirstlane(tid >> 6);
    const int qg = wid >> 1, vg = wid & 1, r32 = lane & 31, hh = lane >> 5;
    constexpr int QL = 0, KV0 = 65536, KVS = 49152, VOF = 16384, SCR = 65536;
    const size_t rowbase = (size_t)b * SEQ;
#pragma unroll
    for (int i = 0; i < 8; ++i) { const int c = tid + 512 * i, row = c >> 5, ch = c & 31;
        const v4u v = *(const GAS v4u*)(Qg + (rowbase + qb * 128 + row) * 1024 + h * 256 + ch * 8);
        *(LAS v4u*)(lds + QL + row * 512 + ((ch ^ (row & 15)) << 4)) = v; }
    const int kr0 = 2 * wid + (lane >> 5);
    const bf16* ksrc = Kg + (rowbase + kr0) * 1024 + h * 256 + (((lane & 31) ^ (kr0 & 15)) * 8);
    const bf16* vsrc = Vg + (rowbase + ((lane & 31) >> 2)) * 2048 + h * 512 + 32 * kr0 + 8 * (lane & 3);
#define RET_DMA_K(kt) do { _Pragma("unroll") for (int i = 0; i < 2; ++i) \
    __builtin_amdgcn_global_load_lds((const unsigned*)(ksrc + ((size_t)(kt) * 32 + 16 * i) * 1024), (LAS unsigned*)(lds + KV0 + ((kt) & 1) * KVS + (wid + 8 * i) * 1024), 16, 0, 0); } while (0)
#define RET_DMA_V(kt) do { _Pragma("unroll") for (int i = 0; i < 4; ++i) \
    __builtin_amdgcn_global_load_lds((const unsigned*)(vsrc + ((size_t)(kt) * 32 + 8 * i) * 2048), (LAS unsigned*)(lds + KV0 + ((kt) & 1) * KVS + VOF + (wid + 8 * i) * 1024), 16, 0, 0); } while (0)
    RET_DMA_K(0); RET_DMA_V(0); RET_DMA_K(1); RET_DMA_V(1);
    asm volatile("s_waitcnt vmcnt(6)" ::: "memory"); __syncthreads();
    f32x16 o[8];
#pragma unroll
    for (int d = 0; d < 8; ++d) o[d] = (f32x16){};
    const int nq = qb * 128 + qg * 32 + r32, sw = r32 & 7; (void)sw;
    const int q0w = qb * 128 + qg * 32;
    float fa[4], fb[4], ba[4], bb[4];
#pragma unroll
    for (int j = 0; j < 4; ++j) {
#define UNI(x) __builtin_bit_cast(float, __builtin_amdgcn_readfirstlane(__builtin_bit_cast(int, (float)(x))))
        fa[j] = UNI(__builtin_amdgcn_exp2f(-lf * (float)j)); fb[j] = UNI(__builtin_amdgcn_exp2f(-lf * (float)(8 * j))); ba[j] = UNI(__builtin_amdgcn_exp2f(lb * (float)j)); bb[j] = UNI(__builtin_amdgcn_exp2f(lb * (float)(8 * j)));
#undef UNI
    }
    const unsigned sw16 = (unsigned)(r32 & 15);
    const unsigned kbase = (unsigned)(unsigned long long)(lds + KV0 + r32 * 512), qbase = (unsigned)(unsigned long long)(lds + QL + (qg * 32 + r32) * 512);
#define KADR(si) (kbase + (((unsigned)(2 * (si) + hh) ^ sw16) << 4))
#define QADR(si) (qbase + (((unsigned)(2 * (si) + hh) ^ sw16) << 4))
    const unsigned vadr0 = (unsigned)(unsigned long long)(lds + KV0 + VOF + vg * 8 * 512 + (4 * hh + ((lane & 15) >> 2)) * 64 + (((lane >> 4) & 1) * 16 + 4 * (lane & 3)) * 2);
    const unsigned vadr1 = vadr0 + KVS;
#define DSR128(dst, adr, imm) asm volatile("ds_read_b128 %0, %1 offset:%2" : "=v"(dst) : "v"(adr), "i"(imm))
#define DSRTR(dst, adr, imm) asm volatile("ds_read_b64_tr_b16 %0, %1 offset:%2" : "=v"(dst) : "v"(adr), "i"(imm))
#define WAITL(n) do { asm volatile("s_waitcnt lgkmcnt(" #n ")" ::: "memory"); __builtin_amdgcn_sched_barrier(0); } while (0)
#ifndef RET_SREP
#define RET_SREP 1
#endif
#ifndef RET_TRDUP
#define RET_TRDUP 0
#endif
#ifndef RET_DECREP
#define RET_DECREP 1
#endif
#ifndef RET_PVREP
#define RET_PVREP 1
#endif
#ifndef RET_BARREP
#define RET_BARREP 1
#endif
#ifndef RET_DMADUP
#define RET_DMADUP 1
#endif
#define RET_DMA_K1(kt, i) __builtin_amdgcn_global_load_lds((const unsigned*)(ksrc + ((size_t)(kt) * 32 + 16 * (i)) * 1024), (LAS unsigned*)(lds + KV0 + ((kt) & 1) * KVS + (wid + 8 * (i)) * 1024), 16, 0, 0)
#define RET_DMA_V1(kt, i) __builtin_amdgcn_global_load_lds((const unsigned*)(vsrc + ((size_t)(kt) * 32 + 8 * (i)) * 2048), (LAS unsigned*)(lds + KV0 + ((kt) & 1) * KVS + VOF + (wid + 8 * (i)) * 1024), 16, 0, 0)
#define RET_STEP(ST, kt_) do { \
        f32x16 s = (f32x16){}; bf16x8 af[4], qf_[4]; \
        if ((kt_) > 0) cv_store(cv_dst(cdU, cvu * 64 + (kt_) - 1, tid), cvl); \
        cvl = *(const GAS f32x4*)cv_src(cvU, cvV, cvu * 64 + (kt_), tid);     \
        const bool dma_ = (kt_) >= 1 && (kt_) + 1 < SEQ / 32; \
        _Pragma("unroll") for (int j = 0; j < 4; ++j) { DSR128(af[j], KADR(j), (ST) * KVS); DSR128(qf_[j], QADR(j), 0); } \
        _Pragma("unroll") for (int si = 0; si < 16; ++si) { \
            if (si < 13) WAITL(6); else if (si == 13) WAITL(4); else if (si == 14) WAITL(2); else WAITL(0); \
            s = __builtin_amdgcn_mfma_f32_32x32x16_bf16(af[si & 3], qf_[si & 3], s, 0, 0, 0); \
            if (si + 4 < 16) { DSR128(af[si & 3], KADR(si + 4), (ST) * KVS); DSR128(qf_[si & 3], QADR(si + 4), 0); } \
            if (dma_) { if (si < 2) RET_DMA_K1((kt_) + 1, si); else if (si < 6) RET_DMA_V1((kt_) + 1, si - 2); } } \
        s16x4 vlo[4], vhi[4]; \
        _Pragma("unroll") for (int j = 0; j < 4; ++j) { DSRTR(vlo[j], ((ST) ? vadr1 : vadr0), ((2 * (j & 1)) * 16 + (j >> 1)) * 512); DSRTR(vhi[j], ((ST) ? vadr1 : vadr0), ((2 * (j & 1) + 1) * 16 + (j >> 1)) * 512); } \
        const float dbase = (float)(nq - (kt_) * 32 - 4 * hh); unsigned pw[8]; \
        if ((kt_) * 32 + 31 < q0w) {              \
            const float aL = __builtin_amdgcn_exp2f(lf * dbase); const float t0 = aL * fb[0], t1 = aL * fb[1], t2 = aL * fb[2], t3 = aL * fb[3]; \
            _Pragma("unroll") for (int r = 0; r < 16; r += 2) { const float tq = (r >> 2) == 0 ? t0 : (r >> 2) == 1 ? t1 : (r >> 2) == 2 ? t2 : t3; \
                pw[r >> 1] = pg8::cvt_pk_bf16(s[r] * (tq * fa[r & 3]), s[r + 1] * (tq * fa[(r + 1) & 3])); } \
        } else if ((kt_) * 32 > q0w + 31) {       \
            const float aL = __builtin_amdgcn_exp2f(-lb * dbase); const float t0 = aL * bb[0], t1 = aL * bb[1], t2 = aL * bb[2], t3 = aL * bb[3]; \
            _Pragma("unroll") for (int r = 0; r < 16; r += 2) { const float tq = (r >> 2) == 0 ? t0 : (r >> 2) == 1 ? t1 : (r >> 2) == 2 ? t2 : t3; \
                pw[r >> 1] = pg8::cvt_pk_bf16(s[r] * (tq * ba[r & 3]), s[r + 1] * (tq * ba[(r + 1) & 3])); } \
        } else { \
        _Pragma("unroll") for (int r = 0; r < 16; r += 2) { const float d0 = dbase - (float)crow0(r), d1 = dbase - (float)crow0(r + 1); \
            const float w0 = __builtin_amdgcn_exp2f(fminf(lf * d0, -lb * d0)), w1 = __builtin_amdgcn_exp2f(fminf(lf * d1, -lb * d1)); pw[r >> 1] = pg8::cvt_pk_bf16(s[r] * w0, s[r + 1] * w1); } } \
        const bf16x8 pa0 = __builtin_bit_cast(bf16x8, (v4u){pw[0], pw[1], pw[2], pw[3]}), pa1 = __builtin_bit_cast(bf16x8, (v4u){pw[4], pw[5], pw[6], pw[7]}); \
        _Pragma("unroll") for (int j = 0; j < 16; ++j) { \
            if (j < 13) WAITL(6); else if (j == 13) WAITL(4); else if (j == 14) WAITL(2); else WAITL(0); \
            const s16x4 lo_ = vlo[j & 3], hi_ = vhi[j & 3]; const bf16x8 vb_ = (bf16x8){lo_[0], lo_[1], lo_[2], lo_[3], hi_[0], hi_[1], hi_[2], hi_[3]}; \
            o[j >> 1] = __builtin_amdgcn_mfma_f32_32x32x16_bf16((j & 1) ? pa1 : pa0, vb_, o[j >> 1], 0, 0, 0); \
            if (j + 4 < 16) { DSRTR(vlo[j & 3], ((ST) ? vadr1 : vadr0), ((2 * ((j + 4) & 1)) * 16 + ((j + 4) >> 1)) * 512); DSRTR(vhi[j & 3], ((ST) ? vadr1 : vadr0), ((2 * ((j + 4) & 1) + 1) * 16 + ((j + 4) >> 1)) * 512); } } \
        VM_WAIT(); __syncthreads(); } while (0)
    f32x4 cvl = (f32x4){0.f, 0.f, 0.f, 0.f};
#pragma unroll 1
    for (int kt = 0; kt < SEQ / 32; kt += 2) { RET_STEP(0, kt); RET_STEP(1, kt + 1); }
    cv_store(cv_dst(cdU, cvu * 64 + SEQ / 32 - 1, tid), cvl);
#undef RET_STEP
#undef DSR128
#undef KADR
#undef QADR
#undef DSRTR
#undef WAITL
#undef RET_DMA_K
#undef RET_DMA_K1
#undef RET_DMA_V1
#undef RET_DMA_V
    constexpr int SCR2 = 131072;
    { const bf16* gsrc = Gz + (rowbase + qb * 128 + 16 * wid) * 2048 + h * 512 + 8 * lane;
#pragma unroll 1
      for (int i = 0; i < 16; ++i) __builtin_amdgcn_global_load_lds((const unsigned*)(gsrc + (size_t)i * 2048), (LAS unsigned*)(lds + (16 * wid + i) * 1024), 16, 0, 0); }
    float sm[16], sq[16];
#pragma unroll
    for (int r = 0; r < 16; ++r) { float a = 0.f, q = 0.f;
#pragma unroll
        for (int dt = 0; dt < 8; ++dt) { const float v = o[dt][r]; a += v; q += v * v; }
#pragma unroll
        for (int of = 1; of < 32; of <<= 1) { a += __shfl_xor(a, of); q += __shfl_xor(q, of); }
        sm[r] = a; sq[r] = q; if ((r & 1) == 1) __builtin_amdgcn_sched_barrier(0); }
    LAS float* scr = (LAS float*)(lds + SCR2);
    if (r32 == 0) {
#pragma unroll
        for (int r = 0; r < 16; ++r) { const int row = crow0(r) + 4 * hh; scr[((qg * 2 + vg) * 32 + row) * 2] = sm[r]; scr[((qg * 2 + vg) * 32 + row) * 2 + 1] = sq[r]; } }
    VM_WAIT(); __syncthreads();
    float gg[8], gb[8];
#pragma unroll
    for (int dt = 0; dt < 8; ++dt) { const int col = h * 512 + vg * 256 + dt * 32 + r32; gg[dt] = gng[col]; gb[dt] = gnb[col]; }
#pragma unroll
    for (int r = 0; r < 16; ++r) {
        const int row = crow0(r) + 4 * hh;
        const float a = scr[((qg * 2) * 32 + row) * 2] + scr[((qg * 2 + 1) * 32 + row) * 2], q = scr[((qg * 2) * 32 + row) * 2 + 1] + scr[((qg * 2 + 1) * 32 + row) * 2 + 1];
        const float mean = a * (1.f / 512.f), var = q * (1.f / 512.f) - mean * mean, rstd = __builtin_amdgcn_rsqf(var + LN_EPS);
        LAS bf16* lp = (LAS bf16*)(lds + (qg * 32 + row) * 1024) + vg * 256 + r32;
#pragma unroll
        for (int dt = 0; dt < 8; ++dt) {
            const float yn = (o[dt][r] - mean) * rstd * gg[dt] + gb[dt];
            const float g = bf2f(lp[dt * 32]);
            const float z = g * __builtin_amdgcn_rcpf(1.f + __expf(-g)) * yn;
            lp[dt * 32] = (bf16)f2bf(z);
        }
    }
    __syncthreads();
    { bf16* zdst = Gz + (rowbase + qb * 128 + 16 * wid) * 2048 + h * 512 + 8 * lane;
#pragma unroll 4
      for (int i = 0; i < 16; ++i) { const v4u v = *(LAS v4u*)(lds + (16 * wid + i) * 1024 + 16 * lane); *(GAS v4u*)(zdst + (size_t)i * 2048) = v; } }
    __syncthreads();
}

__device__ __forceinline__ void ret_unit16(LAS unsigned char* lds, const bf16* __restrict__ Qg, const bf16* __restrict__ Kg, const bf16* __restrict__ Vg, bf16* Gz,
                                           const float* gng, const float* gnb, float lf, float lb, int b, int h, int qb,
                                           const float* cvU, const float* cvV, unsigned char* cdU, int cvu) {
    int tid = threadIdx.x; asm volatile("" : "+v"(tid));
    const int lane = tid & 63, wid = __builtin_amdgcn_readfirstlane(tid >> 6);
    const int n16 = lane & 15, g4 = lane >> 4;
    constexpr int KV0 = 0, KVS = 49152, VOF = 16384;
    const size_t rowbase = (size_t)b * SEQ;
    const int q0w = qb * 128 + 16 * wid;
    bf16x8 qf[8];
    { const bf16* qr = Qg + (rowbase + q0w + n16) * 1024 + h * 256 + 8 * g4;
#pragma unroll
      for (int s = 0; s < 8; ++s) qf[s] = *(const GAS bf16x8*)(qr + 32 * s); }
    const int kr0 = 2 * wid + (lane >> 5);
    const bf16* ksrc = Kg + (rowbase + kr0) * 1024 + h * 256 + (((lane & 31) ^ (kr0 & 15)) * 8);
    const int vr0 = 4 * wid + (lane >> 4), vx0 = ((vr0 & 3) << 2) | ((vr0 >> 2) & 3);
    const bf16* vsrc = Vg + (rowbase + vr0) * 2048 + h * 512 + 8 * ((lane & 15) ^ vx0);
#define R16_DMA_K1(kt, i) __builtin_amdgcn_global_load_lds((const unsigned*)(ksrc + ((size_t)(kt) * 32 + 16 * (i)) * 1024), (LAS unsigned*)(lds + KV0 + ((kt) & 1) * KVS + (wid + 8 * (i)) * 1024), 16, 0, 0)
#define R16_DMA_V1(kt, i) __builtin_amdgcn_global_load_lds((const unsigned*)(vsrc + (size_t)(kt) * 32 * 2048 + 128 * (i)), (LAS unsigned*)(lds + KV0 + ((kt) & 1) * KVS + VOF + 8192 * (i) + wid * 1024), 16, 0, 0)
#pragma unroll
    for (int t0 = 0; t0 < 2; ++t0) { R16_DMA_K1(t0, 0); R16_DMA_K1(t0, 1); R16_DMA_V1(t0, 0); R16_DMA_V1(t0, 1); R16_DMA_V1(t0, 2); R16_DMA_V1(t0, 3); }
    asm volatile("s_waitcnt vmcnt(6)" ::: "memory"); __syncthreads();
    f32x4 o[32];
#pragma unroll
    for (int d = 0; d < 32; ++d) o[d] = (f32x4){0.f, 0.f, 0.f, 0.f};
    float FA[8], BA[8];
#pragma unroll
    for (int j = 0; j < 8; ++j) {
#define UNI(x) __builtin_bit_cast(float, __builtin_amdgcn_readfirstlane(__builtin_bit_cast(int, (float)(x))))
        const float e_ = (float)(16 * (j >> 2) + (j & 3));
        FA[j] = UNI(__builtin_amdgcn_exp2f(-lf * e_)); BA[j] = UNI(__builtin_amdgcn_exp2f(lb * e_));
#undef UNI
    }
    const int kg0 = 8 * (g4 & 1) + 4 * (g4 >> 1);
    const int pi_ = 8 * ((n16 >> 2) & 1) + 4 * (n16 >> 3) + (n16 & 3);
    unsigned kb[4];
#pragma unroll
    for (int bb = 0; bb < 4; ++bb) kb[bb] = (unsigned)(unsigned long long)(lds + KV0) + 512u * pi_ + 64u * (unsigned)(bb ^ (pi_ >> 2)) + 16u * (unsigned)(g4 ^ (pi_ & 3));
    unsigned vbc[8];
    { const int qq = n16 >> 2, pp = n16 & 3, xx = (qq << 2) | ((kg0 >> 2) & 3);
#pragma unroll
      for (int c = 0; c < 8; ++c) { vbc[c] = (unsigned)(unsigned long long)(lds + KV0 + VOF) + 256u * (unsigned)(kg0 + qq) + 16u * (unsigned)((2 * c + (pp >> 1)) ^ xx) + 8u * (unsigned)(pp & 1); } }
#define DSR128(dst, adr, imm) asm volatile("ds_read_b128 %0, %1 offset:%2" : "=v"(dst) : "v"(adr), "i"(imm))
#define DSRTR(dst, adr, imm) asm volatile("ds_read_b64_tr_b16 %0, %1 offset:%2" : "=v"(dst) : "v"(adr), "i"(imm))
#define WAITL(n) do { asm volatile("s_waitcnt lgkmcnt(" #n ")" ::: "memory"); __builtin_amdgcn_sched_barrier(0); } while (0)
#define R16_VB(ST, c) (vbc[c])
    f32x4 cvl = (f32x4){0.f, 0.f, 0.f, 0.f};
#define R16_STEP(ST, kt_) do { \
        if ((kt_) > 0) cv_store(cv_dst(cdU, cvu * 64 + (kt_) - 1, tid), cvl); \
        cvl = *(const GAS f32x4*)cv_src(cvU, cvV, cvu * 64 + (kt_), tid); \
        const bool dma_ = (kt_) >= 1 && (kt_) + 1 < SEQ / 32; \
        f32x4 s0 = (f32x4){0.f, 0.f, 0.f, 0.f}, s1 = s0; bf16x8 k0r[4], k1r[4]; \
        _Pragma("unroll") for (int j = 0; j < 4; ++j) { DSR128(k0r[j], kb[j & 3], (ST) * KVS + 256 * (j >> 2)); DSR128(k1r[j], kb[j & 3], (ST) * KVS + 8192 + 256 * (j >> 2)); } \
        _Pragma("unroll") for (int si = 0; si < 8; ++si) { \
            if (si < 5) WAITL(6); else if (si == 5) WAITL(4); else if (si == 6) WAITL(2); else WAITL(0); \
            s0 = __builtin_amdgcn_mfma_f32_16x16x32_bf16(k0r[si & 3], qf[si], s0, 0, 0, 0); \
            s1 = __builtin_amdgcn_mfma_f32_16x16x32_bf16(k1r[si & 3], qf[si], s1, 0, 0, 0); \
            if (si + 4 < 8) { DSR128(k0r[si & 3], kb[(si + 4) & 3], (ST) * KVS + 256 * ((si + 4) >> 2)); DSR128(k1r[si & 3], kb[(si + 4) & 3], (ST) * KVS + 8192 + 256 * ((si + 4) >> 2)); } \
            if (dma_ && si < 6) { if (si < 2) R16_DMA_K1((kt_) + 1, si); else R16_DMA_V1((kt_) + 1, si - 2); } } \
        s16x4 vlo[4], vhi[4]; \
        _Pragma("unroll") for (int j = 0; j < 4; ++j) { DSRTR(vlo[j], R16_VB(ST, j & 7), 8192 * (j >> 3)); DSRTR(vhi[j], R16_VB(ST, j & 7), 8192 * (j >> 3) + 4096); } \
        const float dbase = (float)(q0w + n16 - (kt_) * 32 - kg0); float p0[4], p1[4]; \
        if ((kt_) * 32 + 31 < q0w) { \
            const float aL = __builtin_amdgcn_exp2f(lf * dbase); \
            _Pragma("unroll") for (int r = 0; r < 4; ++r) { p0[r] = s0[r] * (aL * FA[r]); p1[r] = s1[r] * (aL * FA[4 + r]); } \
        } else if ((kt_) * 32 > q0w + 15) { \
            const float aL = __builtin_amdgcn_exp2f(-lb * dbase); \
            _Pragma("unroll") for (int r = 0; r < 4; ++r) { p0[r] = s0[r] * (aL * BA[r]); p1[r] = s1[r] * (aL * BA[4 + r]); } \
        } else { \
            _Pragma("unroll") for (int r = 0; r < 4; ++r) { const float d0 = dbase - (float)r, d1 = dbase - (float)(16 + r); \
                p0[r] = s0[r] * __builtin_amdgcn_exp2f(fminf(lf * d0, -lb * d0)); p1[r] = s1[r] * __builtin_amdgcn_exp2f(fminf(lf * d1, -lb * d1)); } } \
        const bf16x8 pa = __builtin_bit_cast(bf16x8, (v4u){pg8::cvt_pk_bf16(p0[0], p0[1]), pg8::cvt_pk_bf16(p0[2], p0[3]), pg8::cvt_pk_bf16(p1[0], p1[1]), pg8::cvt_pk_bf16(p1[2], p1[3])}); \
        _Pragma("unroll") for (int ct = 0; ct < 32; ++ct) { \
            if (ct < 29) WAITL(6); else if (ct == 29) WAITL(4); else if (ct == 30) WAITL(2); else WAITL(0); \
            const s16x4 lo_ = vlo[ct & 3], hi_ = vhi[ct & 3]; const bf16x8 vb_ = (bf16x8){lo_[0], lo_[1], lo_[2], lo_[3], hi_[0], hi_[1], hi_[2], hi_[3]}; \
            o[ct] = __builtin_amdgcn_mfma_f32_16x16x32_bf16(pa, vb_, o[ct], 0, 0, 0); \
            if (ct + 4 < 32) { DSRTR(vlo[ct & 3], R16_VB(ST, (ct + 4) & 7), 8192 * ((ct + 4) >> 3)); DSRTR(vhi[ct & 3], R16_VB(ST, (ct + 4) & 7), 8192 * ((ct + 4) >> 3) + 4096); } \
            } \
        _Pragma("unroll") for (int c = 0; c < 8; ++c) vbc[c] += (ST) ? (unsigned)(-KVS) : (unsigned)KVS; \
        VM_WAIT(); __syncthreads(); } while (0)
#pragma unroll 1
    for (int kt = 0; kt < SEQ / 32; kt += 2) { R16_STEP(0, kt); R16_STEP(1, kt + 1); }
    cv_store(cv_dst(cdU, cvu * 64 + SEQ / 32 - 1, tid), cvl);
#undef R16_STEP
#undef R16_VB
#undef DSR128
#undef DSRTR
#undef WAITL
#undef R16_DMA_K1
#undef R16_DMA_V1
    { const bf16* gsrc = Gz + (rowbase + qb * 128 + 16 * wid) * 2048 + h * 512 + 8 * lane;
#pragma unroll 1
      for (int i = 0; i < 16; ++i) __builtin_amdgcn_global_load_lds((const unsigned*)(gsrc + (size_t)i * 2048), (LAS unsigned*)(lds + (16 * wid + i) * 1024), 16, 0, 0); }
    float mean[4], rstd[4];
#pragma unroll
    for (int r = 0; r < 4; ++r) { float a = 0.f, q = 0.f;
#pragma unroll
        for (int ct = 0; ct < 32; ++ct) { const float v = o[ct][r]; a += v; q += v * v; }
#define R16_ROR(x, c) x += __builtin_bit_cast(float, __builtin_amdgcn_update_dpp(0, __builtin_bit_cast(int, x), c, 0xf, 0xf, false))
        R16_ROR(a, 0x128); R16_ROR(q, 0x128); R16_ROR(a, 0x124); R16_ROR(q, 0x124); R16_ROR(a, 0x122); R16_ROR(q, 0x122); R16_ROR(a, 0x121); R16_ROR(q, 0x121);
#undef R16_ROR
        mean[r] = a * (1.f / 512.f); rstd[r] = __builtin_amdgcn_rsqf(q * (1.f / 512.f) - mean[r] * mean[r] + LN_EPS); }
    VM_WAIT(); __syncthreads();
#pragma unroll
    for (int ct = 0; ct < 32; ++ct) {
        const int col = h * 512 + 16 * ct + n16; const float gg = gng[col], gb = gnb[col];
#pragma unroll
        for (int r = 0; r < 4; ++r) {
            LAS bf16* lp = (LAS bf16*)(lds + (16 * wid + 4 * g4 + r) * 1024) + 16 * ct + n16;
            const float yn = (o[ct][r] - mean[r]) * rstd[r] * gg + gb;
            const float g = bf2f(*lp);
            *lp = (bf16)f2bf(g * __builtin_amdgcn_rcpf(1.f + __expf(-g)) * yn);
        }
    }
    __syncthreads();
    { bf16* zdst = Gz + (rowbase + qb * 128 + 16 * wid) * 2048 + h * 512 + 8 * lane;
#pragma unroll 4
      for (int i = 0; i < 16; ++i) { const v4u v = *(LAS v4u*)(lds + (16 * wid + i) * 1024 + 16 * lane); *(GAS v4u*)(zdst + (size_t)i * 2048) = v; } }
    __syncthreads();
}

__device__ __forceinline__ void mla_unit(LAS unsigned char* lds, const bf16* __restrict__ Qg, const bf16* __restrict__ KVg, const bf16* __restrict__ KRg, bf16* Og, int b, int h, int qb) {
    int tid = threadIdx.x; asm volatile("" : "+v"(tid));
    const int lane = tid & 63, wid = __builtin_amdgcn_readfirstlane(tid >> 6);
    const int r32 = lane & 31, hh = lane >> 5;
    constexpr int STG = 40960, KOFF = 0, VOFF = 24576, SCR = 122880;
    const size_t rowbase = (size_t)b * SEQ;
    bf16x8 qf[12];
    { const bf16* qr = Qg + (rowbase + qb * 256 + wid * 32 + r32) * 1536;
#pragma unroll
      for (int s = 0; s < 8; ++s) qf[s] = *(const GAS bf16x8*)(qr + h * 128 + 16 * s + 8 * hh);
#pragma unroll
      for (int s = 0; s < 2; ++s) { qf[8 + s] = *(const GAS bf16x8*)(qr + 1024 + 256 * (h >> 2) + (h & 3) * 32 + 16 * s + 8 * hh);
                                    qf[10 + s] = *(const GAS bf16x8*)(qr + 1024 + 256 * (h >> 2) + 128 + (h & 3) * 32 + 16 * s + 8 * hh); } }
    const bf16* ksrc[3]; int kstr[3];
#pragma unroll
    for (int i = 0; i < 3; ++i) { const int off = 1024 * (wid + 8 * i) + 16 * lane, row = off / 384, pos = (off % 384) >> 4, ch = pos ^ (row & 7);
        if (ch < 16) { ksrc[i] = KVg + (rowbase + row) * 2048 + h * 256 + ch * 8; kstr[i] = 64 * 2048; }
        else         { ksrc[i] = KRg + (rowbase + row) * 64 + (ch - 16) * 8;       kstr[i] = 64 * 64; } }
    const int vs0 = 2 * wid + (lane >> 5);
    const bf16* vsrc = KVg + (rowbase + 8 * (vs0 >> 2) + ((lane & 31) >> 2)) * 2048 + h * 256 + 128 + 32 * (vs0 & 3) + 8 * (lane & 3);
#define MLA_DMA(kt, buf) do { \
    _Pragma("unroll") for (int i = 0; i < 3; ++i) __builtin_amdgcn_global_load_lds((const unsigned*)(ksrc[i] + (size_t)(kt) * kstr[i]), (LAS unsigned*)(lds + (buf) * STG + KOFF + (wid + 8 * i) * 1024), 16, 0, 0); \
    _Pragma("unroll") for (int i = 0; i < 2; ++i) __builtin_amdgcn_global_load_lds((const unsigned*)(vsrc + ((size_t)(kt) * 64 + 32 * i) * 2048), (LAS unsigned*)(lds + (buf) * STG + VOFF + (wid + 8 * i) * 1024), 16, 0, 0); } while (0)
    MLA_DMA(0, 0); MLA_DMA(1, 1);
    int st = 0;
    f32x16 o[4];
#pragma unroll
    for (int d = 0; d < 4; ++d) o[d] = (f32x16){};
    float mref = -INFINITY, lsum = 0.f;
    const int sw = r32 & 7;
    LAS float* scr = (LAS float*)(lds + SCR) + wid * 64;
    const int vlane = VOFF + (4 * hh + ((lane & 15) >> 2)) * 64 + (((lane >> 4) & 1) * 16 + 4 * (lane & 3)) * 2;
    const unsigned kbase0 = (unsigned)(unsigned long long)(lds + KOFF + r32 * 384), vbase0 = (unsigned)(unsigned long long)(lds + vlane);
    unsigned kc[4];
#pragma unroll
    for (int m = 0; m < 4; ++m) kc[m] = (unsigned)(((2 * m + hh) ^ sw) << 4);
#define DSR128(dst, adr, imm) asm volatile("ds_read_b128 %0, %1 offset:%2" : "=v"(dst) : "v"(adr), "i"(imm))
#define DSRTR(dst, adr, imm) asm volatile("ds_read_b64_tr_b16 %0, %1 offset:%2" : "=v"(dst) : "v"(adr), "i"(imm))
#define WAITL(n) do { asm volatile("s_waitcnt lgkmcnt(" #n ")" ::: "memory"); __builtin_amdgcn_sched_barrier(0); } while (0)
    for (int kt = 0; kt < SEQ / 64; ++kt) {
        if (kt + 1 < SEQ / 64) asm volatile("s_waitcnt vmcnt(5)" ::: "memory"); else asm volatile("s_waitcnt vmcnt(0)" ::: "memory");
        __syncthreads();
        if (kt + 2 < SEQ / 64) { const int s2 = (st == 0) ? 2 : st - 1; MLA_DMA(kt + 2, s2); }
        const unsigned so_ = (unsigned)(st * STG);
        unsigned ka[4];
#pragma unroll
        for (int m = 0; m < 4; ++m) ka[m] = kbase0 + so_ + kc[m];
        const unsigned va = vbase0 + so_;
        f32x16 s0 = (f32x16){}, s1 = (f32x16){};
        { bf16x8 a0r[4], a1r[4];
#pragma unroll
          for (int j = 0; j < 4; ++j) { DSR128(a0r[j], ka[j & 3], 128 * (j >> 2)); DSR128(a1r[j], ka[j & 3], 128 * (j >> 2) + 32 * 384); }
#pragma unroll
          for (int si = 0; si < 12; ++si) {
              if (si < 9) WAITL(6); else if (si == 9) WAITL(4); else if (si == 10) WAITL(2); else WAITL(0);
              s0 = __builtin_amdgcn_mfma_f32_32x32x16_bf16(a0r[si & 3], qf[si], s0, 0, 0, 0);
              s1 = __builtin_amdgcn_mfma_f32_32x32x16_bf16(a1r[si & 3], qf[si], s1, 0, 0, 0);
              if (si + 4 < 12) { DSR128(a0r[si & 3], ka[(si + 4) & 3], 128 * ((si + 4) >> 2)); DSR128(a1r[si & 3], ka[(si + 4) & 3], 128 * ((si + 4) >> 2) + 32 * 384); } } }
        float mx = fmaxf(s0[0], s1[0]);
#pragma unroll
        for (int r = 1; r < 16; ++r) mx = fmaxf(mx, fmaxf(s0[r], s1[r]));
        mx = fmaxf(mx, __shfl_xor(mx, 32));
        if (__any(mx > mref + 8.0f)) {
            const float mnew = fmaxf(mref, mx); const float f = __builtin_amdgcn_exp2f(mref - mnew);
            lsum *= f; mref = mnew;
            if (hh == 0) scr[r32] = f;
            LDS_WAIT(); asm volatile("" ::: "memory");
#pragma unroll
            for (int r = 0; r < 16; ++r) { const float fr_ = scr[crow0(r) + 4 * hh];
#pragma unroll
                for (int d = 0; d < 4; ++d) o[d][r] *= fr_; }
        }
        s16x4 vlo[4], vhi[4];
#define MLA_VOFF(p_, hi_) ((((4 * ((p_) >> 3) + 2 * (((p_) >> 2) & 1) + (hi_)) * 4) + ((p_) & 3)) * 512)
#pragma unroll
        for (int j = 0; j < 4; ++j) { DSRTR(vlo[j], va, MLA_VOFF(j, 0)); DSRTR(vhi[j], va, MLA_VOFF(j, 1)); }
        unsigned pw0[8], pw1[8]; float ps = 0.f;
#pragma unroll
        for (int r = 0; r < 16; r += 2) {
            const float a0 = __builtin_amdgcn_exp2f(s0[r] - mref), a1 = __builtin_amdgcn_exp2f(s0[r + 1] - mref);
            const float b0 = __builtin_amdgcn_exp2f(s1[r] - mref), b1 = __builtin_amdgcn_exp2f(s1[r + 1] - mref);
            ps += (a0 + a1) + (b0 + b1);
            pw0[r >> 1] = pg8::cvt_pk_bf16(a0, a1); pw1[r >> 1] = pg8::cvt_pk_bf16(b0, b1);
        }
        lsum += ps;
        bf16x8 pa[2][2];
        pa[0][0] = __builtin_bit_cast(bf16x8, (v4u){pw0[0], pw0[1], pw0[2], pw0[3]}); pa[0][1] = __builtin_bit_cast(bf16x8, (v4u){pw0[4], pw0[5], pw0[6], pw0[7]});
        pa[1][0] = __builtin_bit_cast(bf16x8, (v4u){pw1[0], pw1[1], pw1[2], pw1[3]}); pa[1][1] = __builtin_bit_cast(bf16x8, (v4u){pw1[4], pw1[5], pw1[6], pw1[7]});
#pragma unroll
        for (int p_ = 0; p_ < 16; ++p_) {
            if (p_ < 13) WAITL(6); else if (p_ == 13) WAITL(4); else if (p_ == 14) WAITL(2); else WAITL(0);
            const s16x4 lo = vlo[p_ & 3], hi = vhi[p_ & 3];
            const bf16x8 vv = (bf16x8){lo[0], lo[1], lo[2], lo[3], hi[0], hi[1], hi[2], hi[3]};
            o[p_ & 3] = __builtin_amdgcn_mfma_f32_32x32x16_bf16(pa[p_ >> 3][(p_ >> 2) & 1], vv, o[p_ & 3], 0, 0, 0);
            if (p_ + 4 < 16) { DSRTR(vlo[p_ & 3], va, MLA_VOFF(p_ + 4, 0)); DSRTR(vhi[p_ & 3], va, MLA_VOFF(p_ + 4, 1)); }
        }
#undef MLA_VOFF
        st = (st == 2) ? 0 : st + 1;
    }
#undef MLA_DMA
#undef DSR128
#undef DSRTR
#undef WAITL
    lsum += __shfl_xor(lsum, 32);
    if (hh == 0) scr[32 + r32] = lsum;
    LDS_WAIT(); asm volatile("" ::: "memory");
#pragma unroll
    for (int r = 0; r < 16; ++r) {
        const int row = crow0(r) + 4 * hh; const float il = 1.f / scr[32 + row];
        bf16* op = Og + (rowbase + qb * 256 + wid * 32 + row) * 1024 + h * 128 + r32;
#pragma unroll
        for (int dt = 0; dt < 4; ++dt) op[dt * 32] = (bf16)f2bf(o[dt][r] * il);
    }
    __syncthreads();
}

#define INS16(L, xin) do { float xx_ = (xin); _Pragma("unroll") for (int i_ = 0; i_ < 16; ++i_) { const float t_ = vmaxf(L[i_], xx_); xx_ = vminf(L[i_], xx_); L[i_] = t_; } } while (0)
__device__ __forceinline__ void topk_unit(LAS unsigned char* lds, const bf16* __restrict__ Qp, const bf16* __restrict__ SK, int* seli, float* selg, int tt, int h) {
    int tid = threadIdx.x; asm volatile("" : "+v"(tid));
    const int lane = tid & 63, wid = __builtin_amdgcn_readfirstlane(tid >> 6);
    const int r32 = lane & 31, hh = lane >> 5, sw = r32 & 7;
    const int token = tt * 256 + wid * 32 + r32;
    float AB[2][16];
#pragma unroll
    for (int c = 0; c < 2; ++c) {
        __syncthreads();
#pragma unroll
        for (int i = 0; i < 4; ++i) { const int cc = tid + 512 * i, row = cc >> 4, ch = cc & 15;
            const v4u v = *(const GAS v4u*)(SK + ((size_t)(h * 2 + c) * 128 + row) * 128 + ch * 8);
            *(LAS v4u*)(lds + row * 256 + ((ch ^ (row & 7)) << 4)) = v; }
        bf16x8 qf[8];
#pragma unroll
        for (int s = 0; s < 8; ++s) qf[s] = *(const GAS bf16x8*)(Qp + (size_t)token * 2048 + h * 256 + c * 128 + 16 * s + 8 * hh);
        __syncthreads();
        float L[16];
#pragma unroll
        for (int kt = 0; kt < 4; ++kt) {
            f32x16 acc = (f32x16){};
#pragma unroll
            for (int s = 0; s < 8; ++s) { const bf16x8 a = *(const LAS bf16x8*)(lds + (kt * 32 + r32) * 256 + (((2 * s + hh) ^ sw) << 4));
                acc = __builtin_amdgcn_mfma_f32_32x32x16_bf16(a, qf[s], acc, 0, 0, 0); }
            float G[16];
#pragma unroll
            for (int r = 0; r < 16; ++r) { const unsigned key = (unsigned)(kt * 32 + crow0(r)) + 4u * (unsigned)hh;
                const float av = acc[r];
                G[r] = __builtin_bit_cast(float, (__builtin_bit_cast(unsigned, av) & ~127u) | key); }
#pragma unroll
            for (int k = 2; k <= 16; k <<= 1)
#pragma unroll
                for (int j = k >> 1; j >= 1; j >>= 1)
#pragma unroll
                    for (int i = 0; i < 16; ++i) { const int l = i ^ j; if (l > i) { const float hi_ = vmaxf(G[i], G[l]), lo_ = vminf(G[i], G[l]); if ((i & k) == 0) { G[i] = hi_; G[l] = lo_; } else { G[i] = lo_; G[l] = hi_; } } }
            if (kt == 0) {
#pragma unroll
                for (int i = 0; i < 16; ++i) L[i] = G[i];
            } else {
#pragma unroll
                for (int i = 0; i < 16; ++i) L[i] = vmaxf(L[i], G[15 - i]);
#pragma unroll
                for (int d = 8; d >= 1; d >>= 1)
#pragma unroll
                    for (int i = 0; i < 16; ++i) if ((i & d) == 0) { const float a = vmaxf(L[i], L[i + d]), bq = vminf(L[i], L[i + d]); L[i] = a; L[i + d] = bq; }
            }
        }
        float M[16];
#pragma unroll
        for (int i = 0; i < 16; ++i) M[i] = vmaxf(L[i], __shfl_xor(L[15 - i], 32));
#pragma unroll
        for (int d = 8; d >= 1; d >>= 1)
#pragma unroll
            for (int i = 0; i < 16; ++i) if ((i & d) == 0) { const float a = vmaxf(M[i], M[i + d]), bq = vminf(M[i], M[i + d]); M[i] = a; M[i + d] = bq; }
#pragma unroll
        for (int i = 0; i < 16; ++i) AB[c][i] = M[i];
    }
    float W[16];
#pragma unroll
    for (int j = 0; j < 16; ++j) { const float sum = AB[0][0] + AB[1][j]; const float x = __builtin_bit_cast(float, (__builtin_bit_cast(unsigned, sum) & ~255u) | (unsigned)j); W[j] = hh ? -INFINITY : x; }
    {
        float cand[34]; int nc = 0;
#pragma unroll
        for (int i = 1; i < 16; ++i)
#pragma unroll
            for (int j = 0; j < 16; ++j) if ((i + 1) * (j + 1) <= 16) { const float sum = AB[0][i] + AB[1][j];
                cand[nc++] = __builtin_bit_cast(float, (__builtin_bit_cast(unsigned, sum) & ~255u) | (unsigned)(i * 16 + j)); }
#pragma unroll
        for (int c = 0; c < 17; ++c) { float xe = cand[2 * c], xo = cand[2 * c + 1]; asm volatile("" : "+v"(xe), "+v"(xo)); const float x = hh ? xo : xe; INS16(W, x); }
#pragma unroll
        for (int i = 0; i < 16; ++i) cand[i] = __shfl_xor(W[15 - i], 32);
#pragma unroll
        for (int i = 0; i < 16; ++i) W[i] = vmaxf(W[i], cand[i]);
#pragma unroll
        for (int d = 8; d >= 1; d >>= 1)
#pragma unroll
            for (int i = 0; i < 16; ++i) if ((i & d) == 0) { const float a = vmaxf(W[i], W[i + d]), bq = vminf(W[i], W[i + d]); W[i] = a; W[i + d] = bq; }
    }
    LAS unsigned char* tb = lds + 32768 + wid * 1024 + r32 * 32;
    if (hh == 0) {
#pragma unroll
        for (int c = 0; c < 2; ++c)
#pragma unroll
            for (int q = 0; q < 4; ++q) { unsigned w = 0;
#pragma unroll
                for (int e = 0; e < 4; ++e) w |= (__builtin_bit_cast(unsigned, AB[c][4 * q + e]) & 127u) << (8 * e);
                *(LAS unsigned*)(tb + c * 16 + 4 * q) = w; }
    }
    LDS_WAIT(); asm volatile("" ::: "memory");
    float Z = 0.f;
#pragma unroll
    for (int k = 0; k < 16; ++k) Z += __expf(W[k] - W[0]);
    const float iz = 1.f / Z;
    int ei[8]; float eg[8];
#pragma unroll
    for (int k = 0; k < 8; ++k) {
        float wa_ = W[k], wb_ = W[8 + k]; asm volatile("" : "+v"(wa_), "+v"(wb_));
        const float w = hh ? wb_ : wa_;
        const unsigned ij = __builtin_bit_cast(unsigned, w) & 255u;
        const unsigned k1 = tb[ij >> 4], k2 = tb[16 + (ij & 15)];
        ei[k] = (int)(k1 * 128u + k2); eg[k] = __expf(w - W[0]) * iz;
    }
    int* ip = seli + (size_t)token * 128 + h * 16 + 8 * hh; float* gp = selg + (size_t)token * 128 + h * 16 + 8 * hh;
    *(GAS v4u*)ip = (v4u){(unsigned)ei[0], (unsigned)ei[1], (unsigned)ei[2], (unsigned)ei[3]}; *(GAS v4u*)(ip + 4) = (v4u){(unsigned)ei[4], (unsigned)ei[5], (unsigned)ei[6], (unsigned)ei[7]};
    *(GAS f32x4*)gp = (f32x4){eg[0], eg[1], eg[2], eg[3]}; *(GAS f32x4*)(gp + 4) = (f32x4){eg[4], eg[5], eg[6], eg[7]};
}

__device__ __forceinline__ void topk_brute_unit(LAS unsigned char* lds, const bf16* __restrict__ Qp, const bf16* __restrict__ SK, int* seli, float* selg, int tt, int h) {
    const int tid = threadIdx.x;
    const int token = tt * 512 + tid;
    float AB[2][16];
#pragma unroll
    for (int c = 0; c < 2; ++c) {
        __syncthreads();
#pragma unroll
        for (int i = 0; i < 4; ++i) { const int cc = tid + 512 * i, row = cc >> 4, ch = cc & 15;
            const v4u v = *(const GAS v4u*)(SK + ((size_t)(h * 2 + c) * 128 + row) * 128 + ch * 8);
            *(LAS v4u*)(lds + row * 256 + (ch << 4)) = v; }
        __syncthreads();
        unsigned q[64];
#pragma unroll
        for (int i = 0; i < 16; ++i) { const v4u v = *(const GAS v4u*)(Qp + (size_t)token * 2048 + h * 256 + c * 128 + i * 8); q[4 * i] = v.x; q[4 * i + 1] = v.y; q[4 * i + 2] = v.z; q[4 * i + 3] = v.w; }
        float L[16];
#pragma unroll
        for (int i = 0; i < 16; ++i) L[i] = -INFINITY;
#pragma unroll 1
        for (int key = 0; key < 128; ++key) {
            float s = 0.f;
#pragma unroll
            for (int i = 0; i < 64; ++i) { const unsigned kw = *(const LAS unsigned*)(lds + key * 256 + i * 4);
                s += __builtin_bit_cast(float, kw << 16) * __builtin_bit_cast(float, q[i] << 16) + __builtin_bit_cast(float, kw & 0xffff0000u) * __builtin_bit_cast(float, q[i] & 0xffff0000u); }
            const float x = __builtin_bit_cast(float, (__builtin_bit_cast(unsigned, s) & ~127u) | (unsigned)key); INS16(L, x);
        }
#pragma unroll
        for (int i = 0; i < 16; ++i) AB[c][i] = L[i];
    }
    float W[16];
#pragma unroll
    for (int i = 0; i < 16; ++i) W[i] = -INFINITY;
#pragma unroll
    for (int i = 0; i < 16; ++i)
#pragma unroll
        for (int j = 0; j < 16; ++j) if ((i + 1) * (j + 1) <= 16) {
            const float sum = AB[0][i] + AB[1][j];
            const float x = __builtin_bit_cast(float, (__builtin_bit_cast(unsigned, sum) & ~255u) | (unsigned)(i * 16 + j)); INS16(W, x); }
    __syncthreads();
    LAS unsigned char* tb = lds + tid * 32;
#pragma unroll
    for (int c = 0; c < 2; ++c)
#pragma unroll
        for (int qd = 0; qd < 4; ++qd) { unsigned w = 0;
#pragma unroll
            for (int e = 0; e < 4; ++e) w |= (__builtin_bit_cast(unsigned, AB[c][4 * qd + e]) & 127u) << (8 * e);
            *(LAS unsigned*)(tb + c * 16 + 4 * qd) = w; }
    LDS_WAIT(); asm volatile("" ::: "memory");
    float Z = 0.f;
#pragma unroll
    for (int k = 0; k < 16; ++k) Z += __expf(W[k] - W[0]);
    const float iz = 1.f / Z;
#pragma unroll
    for (int k = 0; k < 16; ++k) {
        const unsigned ij = __builtin_bit_cast(unsigned, W[k]) & 255u;
        const unsigned k1 = tb[ij >> 4], k2 = tb[16 + (ij & 15)];
        seli[(size_t)token * 128 + h * 16 + k] = (int)(k1 * 128u + k2); selg[(size_t)token * 128 + h * 16 + k] = __expf(W[k] - W[0]) * iz;
    }
}

typedef float f32x2 __attribute__((ext_vector_type(2)));
#ifndef PGV_SYNC
#define PGV_SYNC 4
#endif
constexpr float PEER_CSC = 32.0f;
constexpr float PEER_TSCALE = 256.0f;
__device__ __forceinline__ float reduce8(const float (&p)[8], int lane) {
    const bool h5 = (lane & 32) != 0, h4 = (lane & 16) != 0, h3 = (lane & 8) != 0;
    float q[4], r[2];
#pragma unroll
    for (int j = 0; j < 4; ++j) { const float send = h5 ? p[j] : p[4 + j], keep = h5 ? p[4 + j] : p[j]; q[j] = keep + __shfl_xor(send, 32); }
#pragma unroll
    for (int j = 0; j < 2; ++j) { const float send = h4 ? q[j] : q[2 + j], keep = h4 ? q[2 + j] : q[j]; r[j] = keep + __shfl_xor(send, 16); }
    const float send = h3 ? r[0] : r[1], keep = h3 ? r[1] : r[0];
    float s = keep + __shfl_xor(send, 8);
    s += __shfl_xor(s, 4); s += __shfl_xor(s, 2); s += __shfl_xor(s, 1);
    return s;
}
typedef long i64_t;
__device__ __forceinline__ i64_t mk64(unsigned lo, unsigned hi) { return (i64_t)(((unsigned long long)hi << 32) | (unsigned long long)lo); }
template <int variant>
__device__ __forceinline__ void peer_gather(const Frame& F, float* H, bf16* HB, const int* seli, const float* selg, const unsigned char* __restrict__ PU, const unsigned char* __restrict__ PV, const float* lng, const float* lnb,
                                            const float* STAT, const float* g1, const float* b1) {
    int lane = F.lane; asm volatile("" : "+v"(lane));
    const int gw = F.vcu * NWAVES + F.wave, NGW = F.G * NWAVES, r16 = lane & 15, kg = lane >> 4;
#ifndef ABL_PEER
#define ABL_PEER 1.0f
#endif
    LAS unsigned char* wb = F.lds + F.wave * 16384;
    LAS unsigned char* x8 = wb;
    LAS unsigned short* elist = (LAS unsigned short*)(wb + 4096);
    LAS unsigned char* tlist = wb + 5120;
    LAS float* dc = (LAS float*)(wb + 5632);
    LAS unsigned short* posT = (LAS unsigned short*)(wb + 7680);
    LAS int* cnt = (LAS int*)(wb + 8704);
    LAS int* gtab = (LAS int*)(wb + 9216);
    LAS int* otab = (LAS int*)(wb + 9728);
    LAS float* dd = (LAS float*)(wb + 10240);
#pragma unroll 1
    for (int round = 0; round < 2; ++round) {
        {
            int ia[4], ib[4], pa[4], pb[4]; float ga[4], gb[4];
#pragma unroll
            for (int i = 0; i < 4; ++i) { const size_t o = (size_t)(gw + NGW * (4 * round + i)) * 128 + lane; ia[i] = seli[o]; ib[i] = seli[o + 64]; ga[i] = selg[o]; gb[i] = selg[o + 64]; }
            cnt[lane] = 0; cnt[64 + lane] = 0;
            LDS_WAIT(); asm volatile("" ::: "memory");
#pragma unroll
            for (int i = 0; i < 4; ++i) { pa[i] = __hip_atomic_fetch_add(cnt + (ia[i] >> 9) * 4 + i, 1, __ATOMIC_RELAXED, __HIP_MEMORY_SCOPE_WORKGROUP);
                                          pb[i] = __hip_atomic_fetch_add(cnt + (ib[i] >> 9) * 4 + i, 1, __ATOMIC_RELAXED, __HIP_MEMORY_SCOPE_WORKGROUP); }
            LDS_WAIT(); asm volatile("" ::: "memory");
            { const int n0 = cnt[2 * lane], n1 = cnt[2 * lane + 1]; int s = n0 + n1;
#pragma unroll
              for (int d = 1; d < 64; d <<= 1) { const int tt = __shfl_up(s, d); if (lane >= d) s += tt; }
              const int base = s - n0 - n1;
              int pk = 0;
              if (lane < 32) {
#pragma unroll
                  for (int i = 0; i < 4; ++i) pk |= cnt[lane * 4 + i] << (8 * i); }
              int ps = pk;
#pragma unroll
              for (int d = 1; d < 32; d <<= 1) { const int tt = __shfl_up(ps, d); if (lane >= d) ps += tt; }
              ps -= pk;
              LDS_WAIT(); asm volatile("" ::: "memory");
              gtab[2 * lane] = base; gtab[2 * lane + 1] = base + n0;
              if (lane < 32) {
#pragma unroll
                  for (int i = 0; i < 4; ++i) otab[i * 32 + lane] = (ps >> (8 * i)) & 255; } }
            LDS_WAIT(); asm volatile("" ::: "memory");
#pragma unroll
            for (int i = 0; i < 4; ++i) { const int wa = ia[i] >> 9, wb_ = ib[i] >> 9;
                const int qa = gtab[wa * 4 + i] + pa[i], qb = gtab[wb_ * 4 + i] + pb[i], sa = otab[i * 32 + wa] + pa[i], sb = otab[i * 32 + wb_] + pb[i];
                elist[qa] = (unsigned short)ia[i]; elist[qb] = (unsigned short)ib[i]; tlist[qa] = (unsigned char)i; tlist[qb] = (unsigned char)i; dc[qa] = ga[i]; dc[qb] = gb[i];
                posT[i * 128 + sa] = (unsigned short)qa; posT[i * 128 + sb] = (unsigned short)qb; }
#pragma unroll
            for (int i = 0; i < 4; ++i) { const bf16* xp = HB + (size_t)(gw + NGW * (4 * round + i)) * DM + 16 * lane;
                const v4u xa = *(const GAS v4u*)xp, xb = *(const GAS v4u*)(xp + 8);
                const unsigned w0 = xa.x, w1 = xa.y, w2 = xa.z, w3 = xa.w, w4 = xb.x, w5 = xb.y, w6 = xb.z, w7 = xb.w;
#define LOF(w) __builtin_bit_cast(float, (w) << 16)
#define HIF(w) __builtin_bit_cast(float, (w) & 0xffff0000u)
#define PK4(wa, wb_) __builtin_amdgcn_cvt_pk_fp8_f32(LOF(wb_), HIF(wb_), __builtin_amdgcn_cvt_pk_fp8_f32(LOF(wa), HIF(wa), 0, false), true)
                const v4u o = (v4u){(unsigned)PK4(w0, w1), (unsigned)PK4(w2, w3), (unsigned)PK4(w4, w5), (unsigned)PK4(w6, w7)};
#undef PK4
#undef LOF
#undef HIF
                *(LAS v4u*)(x8 + i * 1024 + 16 * lane) = o; }
        }
        LDS_WAIT(); asm volatile("" ::: "memory");
        {
#define PGU_LOAD(buf, EV, TV, g_) do { EV = (int)elist[8 * (g_) + (lane & 7)]; TV = (int)tlist[8 * (g_) + (lane & 7)]; \
            _Pragma("unroll") for (int k = 0; k < 8; ++k) { const int idx = __builtin_amdgcn_readlane(EV, k); buf[k] = *(const GAS v4u*)(PU + (size_t)idx * DM + 16 * lane); } } while (0)
#define PGU_COMP(buf, TV, g_) do { float p_[8]; v4u xa_[8]; f32x4 D_[8]; \
            _Pragma("unroll") for (int k = 0; k < 8; ++k) { const int tk_ = __builtin_amdgcn_readlane(TV, k); xa_[k] = *(const LAS v4u*)(x8 + tk_ * 1024 + 16 * lane); } \
            _Pragma("unroll") for (int k = 0; k < 8; ++k) { const unsigned a0 = xa_[k].x, a1 = xa_[k].y, b0 = buf[k].x, b1 = buf[k].y; \
                D_[k] = __builtin_amdgcn_mfma_f32_16x16x32_fp8_fp8(mk64(a0, a1), mk64(b0, b1), (f32x4){0.f, 0.f, 0.f, 0.f}, 0, 0, 0); } \
            _Pragma("unroll") for (int k = 0; k < 8; ++k) { const unsigned a2 = xa_[k].z, a3 = xa_[k].w, b2 = buf[k].z, b3 = buf[k].w; \
                D_[k] = __builtin_amdgcn_mfma_f32_16x16x32_fp8_fp8(mk64(a2, a3), mk64(b2, b3), D_[k], 0, 0, 0); } \
            _Pragma("unroll") for (int k = 0; k < 8; ++k) { const float da_ = D_[k][0], db_ = D_[k][1], dc_ = D_[k][2], dd_ = D_[k][3]; p_[k] = (da_ * tw0 + db_ * tw1) + (dc_ * tw2 + dd_ * tw3); } \
            const float tot_ = reduce8(p_, lane); \
            if ((lane & 7) == 0) dd[8 * (g_) + (lane >> 3)] = tot_ * (1.0f / PEER_TSCALE); } while (0)
            const float tw0 = (kg == (r16 >> 2) && (r16 & 3) == 0) ? 1.f : 0.f, tw1 = (kg == (r16 >> 2) && (r16 & 3) == 1) ? 1.f : 0.f,
                        tw2 = (kg == (r16 >> 2) && (r16 & 3) == 2) ? 1.f : 0.f, tw3 = (kg == (r16 >> 2) && (r16 & 3) == 3) ? 1.f : 0.f;
            v4u bA[8], bB[8]; int EA, EB, TA, TB;
            PGU_LOAD(bA, EA, TA, 0);
#pragma unroll 1
            for (int g = 0; g < 64; g += 2) {
                PGU_LOAD(bB, EB, TB, g + 1);
                PGU_COMP(bA, TA, g);
                if (g + 2 < 64) PGU_LOAD(bA, EA, TA, g + 2);
                PGU_COMP(bB, TB, g + 1);
#ifdef PGU_SYNC
                if ((g & (PGU_SYNC - 1)) == 0) __builtin_amdgcn_s_barrier();
#endif
            }
#undef PGU_LOAD
#undef PGU_COMP
        }
        LDS_WAIT(); asm volatile("" ::: "memory");
#pragma unroll
        for (int j = 0; j < 8; ++j) { const int gp = 64 * j + lane; const float d_ = dd[gp]; dc[gp] = fminf(fmaxf(PEER_CSC * dc[gp] * 0.5f * d_ * (1.f + erff(d_ * 0.70710678118654752f)), -448.f), 448.f); }
        LDS_WAIT(); asm volatile("" ::: "memory");
        typedef unsigned v2u_t __attribute__((ext_vector_type(2)));
        LAS v2u_t* ec = (LAS v2u_t*)(wb + 12288);
#pragma unroll
        for (int j = 0; j < 8; ++j) { const int n = 64 * j + lane; const int pos = (int)posT[n]; const float cf_ = dc[pos];
            const unsigned c8 = (unsigned)__builtin_amdgcn_cvt_pk_fp8_f32(cf_, cf_, 0, false) & 0xffu; ec[n] = (v2u_t){(unsigned)elist[pos], c8 * 0x01010101u}; }
        LDS_WAIT(); asm volatile("" ::: "memory");
        {
            const int q = lane >> 4, s16 = lane & 15;
            unsigned m1lo, m1hi, m2lo, m2hi;
            { const unsigned bm = 0xffu << (8 * (s16 & 3)); const bool lo_ = (s16 & 7) < 4; const bool s1 = q == (s16 >> 3), s2 = q == 2 + (s16 >> 3);
              m1lo = (s1 && lo_) ? bm : 0u; m1hi = (s1 && !lo_) ? bm : 0u; m2lo = (s2 && lo_) ? bm : 0u; m2hi = (s2 && !lo_) ? bm : 0u; }
            const LAS v2u_t* ecq = ec + q * 128;
            const unsigned char* pvl = PV + 16 * s16;
            f32x4 D[4][2][2];
#pragma unroll
            for (int j = 0; j < 4; ++j)
#pragma unroll
                for (int h = 0; h < 2; ++h) { D[j][h][0] = (f32x4){0.f, 0.f, 0.f, 0.f}; D[j][h][1] = (f32x4){0.f, 0.f, 0.f, 0.f}; }
            v4u rb[4][4]; unsigned cb[4];
#define PGV_LOAD(b_, e_) do { const v2u_t ic_ = ecq[(e_) < 128 ? (e_) : 127]; const unsigned ix_ = ic_.x, cy_ = ic_.y; cb[b_] = ((e_) < 128) ? cy_ : 0u; const unsigned char* rp_ = pvl + (size_t)ix_ * DM; \
            _Pragma("unroll") for (int j = 0; j < 4; ++j) rb[b_][j] = *(const GAS v4u*)(rp_ + 256 * j); } while (0)
#define PGV_COMP(b_) do { const unsigned c4 = cb[b_]; const i64_t a1 = mk64(c4 & m1lo, c4 & m1hi), a2 = mk64(c4 & m2lo, c4 & m2hi); \
            _Pragma("unroll") for (int j = 0; j < 4; ++j) { const unsigned b0 = rb[b_][j].x, b1 = rb[b_][j].y, b2 = rb[b_][j].z, b3 = rb[b_][j].w; const i64_t blo = mk64(b0, b1), bhi = mk64(b2, b3); \
                D[j][0][0] = __builtin_amdgcn_mfma_f32_16x16x32_fp8_fp8(a1, blo, D[j][0][0], 0, 0, 0); D[j][0][1] = __builtin_amdgcn_mfma_f32_16x16x32_fp8_fp8(a2, blo, D[j][0][1], 0, 0, 0); \
                D[j][1][0] = __builtin_amdgcn_mfma_f32_16x16x32_fp8_fp8(a1, bhi, D[j][1][0], 0, 0, 0); D[j][1][1] = __builtin_amdgcn_mfma_f32_16x16x32_fp8_fp8(a2, bhi, D[j][1][1], 0, 0, 0); } } while (0)
            PGV_LOAD(0, 0); PGV_LOAD(1, 1); PGV_LOAD(2, 2);
#pragma unroll 1
            for (int e0 = 0; e0 < 128; e0 += 4) {
                PGV_LOAD(3, e0 + 3); __builtin_amdgcn_sched_barrier(0); PGV_COMP(0); __builtin_amdgcn_sched_barrier(0);
                if (PGV_SYNC == 1) __builtin_amdgcn_s_barrier();
                PGV_LOAD(0, e0 + 4); __builtin_amdgcn_sched_barrier(0); PGV_COMP(1); __builtin_amdgcn_sched_barrier(0);
                if (PGV_SYNC <= 2) __builtin_amdgcn_s_barrier();
                PGV_LOAD(1, e0 + 5); __builtin_amdgcn_sched_barrier(0); PGV_COMP(2); __builtin_amdgcn_sched_barrier(0);
                if (PGV_SYNC == 1) __builtin_amdgcn_s_barrier();
                PGV_LOAD(2, e0 + 6); __builtin_amdgcn_sched_barrier(0); PGV_COMP(3); __builtin_amdgcn_sched_barrier(0);
                if (PGV_SYNC <= 4 || (e0 & (PGV_SYNC - 1)) == 0) __builtin_amdgcn_s_barrier();
            }
#undef PGV_LOAD
#undef PGV_COMP
            constexpr float YS = ABL_PEER / (PEER_TSCALE * PEER_CSC);
            const int cb_ = 16 * s16 + 4 * (q & 1);
#pragma unroll
            for (int s = 0; s < 2; ++s) {
                const int t = gw + NGW * (4 * round + 2 * s + (lane >> 5));
                float* hrow = H + (size_t)t * DM + cb_;
                const f32x2 st_ = *(const GAS f32x2*)(STAT + 2 * (size_t)t); const float mu1 = st_.x, rs1 = st_.y * DN_ALPHA;
                float sm = 0.f;
#pragma unroll
                for (int j = 0; j < 4; ++j)
#pragma unroll
                    for (int h = 0; h < 2; ++h) { const int co = 256 * j + 8 * h; const f32x4 g1_ = *(const GAS f32x4*)(g1 + cb_ + co), b1_ = *(const GAS f32x4*)(b1 + cb_ + co);
                        const f32x4 v_ = ((*(const GAS f32x4*)(hrow + co) - mu1) * rs1 * g1_ + b1_ * DN_ALPHA) + D[j][h][s] * YS; D[j][h][s] = v_; sm += (v_.x + v_.y) + (v_.z + v_.w); }
#pragma unroll
                for (int of = 1; of < 32; of <<= 1) sm += __shfl_xor(sm, of);
                const float mean = sm * (1.f / DM); float s2 = 0.f;
#pragma unroll
                for (int j = 0; j < 4; ++j)
#pragma unroll
                    for (int h = 0; h < 2; ++h) { const f32x4 v_ = D[j][h][s] - mean; D[j][h][s] = v_; s2 += (v_.x * v_.x + v_.y * v_.y) + (v_.z * v_.z + v_.w * v_.w); }
#pragma unroll
                for (int of = 1; of < 32; of <<= 1) s2 += __shfl_xor(s2, of);
                const float rstd = __builtin_amdgcn_rsqf(s2 * (1.f / DM) + LN_EPS);
                bf16* brow = HB + (size_t)t * DM + cb_;
#pragma unroll
                for (int j = 0; j < 4; ++j)
#pragma unroll
                    for (int h = 0; h < 2; ++h) { const int co = 256 * j + 8 * h;
                        const f32x4 gv_ = *(const GAS f32x4*)(lng + cb_ + co), bv_ = *(const GAS f32x4*)(lnb + cb_ + co);
                        const f32x4 o_ = D[j][h][s] * rstd * gv_ + bv_;
                        *(GAS f32x4*)(hrow + co) = o_;
                        *(GAS v2u_t*)(brow + co) = (v2u_t){pk2(o_.x, o_.y), pk2(o_.z, o_.w)}; }
            }
        }
    }
}
#ifndef RET_UNIT
#define RET_UNIT ret_unit16
#endif
#ifndef MK_SINGLE
#define MK_SINGLE 1
#endif
constexpr int NPH = 17;
#ifndef GV2
#define GV2 0
#endif
#ifndef ABL_RET
#define ABL_RET 1.0f
#endif
#ifndef ABL_MLA
#define ABL_MLA 1.0f
#endif
struct Args { const void* in[21]; float* out; unsigned char* ws; int ph_lo, ph_hi; };
__global__ void __launch_bounds__(NWAVES * 64, 2) mk_fwd(Args args) {
    extern __shared__ __attribute__((aligned(16))) unsigned char lds[];
    Frame F;
    F.lds = (LAS unsigned char*)lds;
    volatile LAS unsigned* MISC = (volatile LAS unsigned*)(F.lds + MISC_OFF);
    F.tid = threadIdx.x; F.lane = F.tid & 63; F.wave = __builtin_amdgcn_readfirstlane(F.tid >> 6);
    F.G = gridDim.x; { const int bx = blockIdx.x; F.vcu = (F.G % 8 == 0) ? (bx % 8) * (F.G / 8) + bx / 8 : bx; }
    Ptrs P;
    P.x = (const float*)args.in[0]; P.pos = (const int*)args.in[1];
    P.ret_w_in = (const float*)args.in[2]; P.ret_decay = (const float*)args.in[3]; P.ret_gn_g = (const float*)args.in[4]; P.ret_gn_b = (const float*)args.in[5]; P.ret_w_out = (const float*)args.in[6];
    P.mla_w_in = (const float*)args.in[7]; P.mla_qn = (const float*)args.in[8]; P.mla_kvn = (const float*)args.in[9]; P.mla_w_uq = (const float*)args.in[10]; P.mla_w_ukv = (const float*)args.in[11]; P.mla_w_out = (const float*)args.in[12];
    P.peer_w_q = (const float*)args.in[13]; P.peer_sk = (const float*)args.in[14]; P.peer_u = (const float*)args.in[15]; P.peer_v = (const float*)args.in[16];
    P.ln_mix_g = (const float*)args.in[17]; P.ln_mix_b = (const float*)args.in[18]; P.ln_ffn_g = (const float*)args.in[19]; P.ln_ffn_b = (const float*)args.in[20];
    P.H = args.out; P.ws = args.ws;
    unsigned char* ws = args.ws;
    gu32* ctl = (gu32*)(ws + WS_CTL);
    for (int u = F.tid; u < (LDS_BYTES - LDSCTL_OFF) / 4; u += NWAVES * 64) ((LAS unsigned*)(F.lds + LDSCTL_OFF))[u] = 0u;
    __syncthreads();
    const int lo = args.ph_lo, hi = args.ph_hi;
    XcdBarrier bar; bar.bar = (unsigned*)(ctl + CW_BAR); bar.x = 0; bar.st = nullptr;
    if (hi - lo > 1) bar = xcd_barrier_post((unsigned*)(ctl + CW_BAR), MISC + 8);
#ifndef PHMASK
#define PHMASK 0x1ffff
#endif
#define IN(k) ((((PHMASK) >> (k)) & 1) && lo <= (k) && (k) < hi)
#define SEAM(k) do { if (IN(k) && IN((k) + 1)) xcd_barrier(bar); } while (0)
#ifndef REP
#define REP -1
#endif
#ifndef REPVAR
#define REPVAR 0
#endif
#define NREP(k) ((REP) == (k) ? 2 : 1)
#define REPBAR(k) do { if (rep + 1 < NREP(k)) xcd_barrier(bar); } while (0)
    float* const STAT = (float*)(ws + WS_CTL + 512 * 1024);
    float* const DUMH = (float*)(ws + 424 * MiB); bf16* const DUMB = (bf16*)(ws + 424 * MiB);
    bf16* HB = (bf16*)(ws + WS_HB);
    int* SELI = (int*)(ws + WS_SELI); float* SELG = (float*)(ws + WS_SELG);

    if (IN(0)) for (int rep = 0; rep < NREP(0); ++rep) { p0_prologue(F, P); REPBAR(0); } SEAM(0);
    if (IN(1)) for (int rep = 0; rep < NREP(1); ++rep) {
        pg8::Gemm g{HB, (const bf16*)(ws + WS_W_RIN), T, 6144, 1024}; pg8::StaticOrder S; S.init(T, 6144, F.G, (int)blockIdx.x);
        pg8::EpiRetIn E{(bf16*)(ws + WS_RQ), (bf16*)(ws + WS_RK), (bf16*)(ws + WS_RV), (bf16*)(ws + WS_RG), P.pos};
        pg8::gemm_phase<pg8::EpiRetIn, pg8::StaticOrder, true, true>(F.lds, g, S, E);
    REPBAR(1); } SEAM(1);
    if (IN(2)) for (int rep = 0; rep < NREP(2); ++rep) {
        unsigned m8 = 0, m9 = 0; if (F.tid == 0) { m8 = MISC[8]; m9 = MISC[9]; }
        for (int u = F.vcu; u < 512; u += F.G) {
            const int bh = u >> 4, qb = u & 15, b = bh >> 2, h = bh & 3;
            const float lf = log1pf(-expf(P.ret_decay[h])) * 1.4426950408889634f, lb = log1pf(-expf(P.ret_decay[4 + h])) * 1.4426950408889634f;
            RET_UNIT(F.lds, (const bf16*)(ws + WS_RQ), (const bf16*)(ws + WS_RK), (const bf16*)(ws + WS_RV), rep ? DUMB : (bf16*)(ws + WS_RG), P.ret_gn_g, P.ret_gn_b, lf, lb, b, h, qb, P.peer_u, P.peer_v, ws + WS_PU, u);
        }
        if (F.tid == 0) { MISC[8] = m8; MISC[9] = m9; } __syncthreads();
    REPBAR(2); } SEAM(2);
    if (IN(3)) for (int rep = 0; rep < NREP(3); ++rep) {
        pg8::Gemm g{(const bf16*)(ws + WS_RG), (const bf16*)(ws + WS_W_ROUT), T, 1024, 2048}; pg8::StaticOrder S; S.init(T, 1024, F.G, (int)blockIdx.x);
        pg8::EpiRes E{P.x, P.H, DN_ALPHA, ABL_RET};
        pg8::gemm_phase<pg8::EpiRes, pg8::StaticOrder, true, true>(F.lds, g, S, E);
    REPBAR(3); } SEAM(3);
    if (IN(4)) for (int rep = 0; rep < NREP(4); ++rep) { ln_rows(F, P.H, rep ? DUMB : HB, P.ln_mix_g, P.ln_mix_b, STAT); REPBAR(4); } SEAM(4);
    if (IN(5)) for (int rep = 0; rep < NREP(5); ++rep) {
        pg8::Gemm g{HB, (const bf16*)(ws + WS_W_PQ), T, 2048, 1024}; pg8::StaticOrder S; S.init(T, 2048, F.G, (int)blockIdx.x);
        pg8::EpiBf E{(bf16*)(ws + WS_QP), 2048};
        pg8::gemm_phase<pg8::EpiBf, pg8::StaticOrder, true, true>(F.lds, g, S, E);
    REPBAR(5); } SEAM(5);
    if (IN(6)) for (int rep = 0; rep < NREP(6); ++rep) {
#ifdef TOPK_BRUTE
        for (int u = F.vcu; u < 256; u += F.G) topk_brute_unit(F.lds, (const bf16*)(ws + WS_QP), (const bf16*)(ws + WS_W_SK), SELI, SELG, u >> 3, u & 7);
#else
        for (int u = F.vcu, ui = 0; u < 512; u += F.G, ++ui) topk_unit(F.lds, (const bf16*)(ws + WS_QP), (const bf16*)(ws + WS_W_SK), SELI, SELG, u >> 3, u & 7);
#endif
    REPBAR(6); } SEAM(6);
    if (IN(7)) for (int rep = 0; rep < NREP(7); ++rep) { peer_gather<GV2>(F, P.H, HB, SELI, SELG, ws + WS_PU, ws + WS_PV, P.ln_ffn_g, P.ln_ffn_b, STAT, P.ln_mix_g, P.ln_mix_b);
#ifdef GVAR
        xcd_barrier(bar); peer_gather<GVAR>(F, (float*)(ws + 424 * MiB), (bf16*)(ws + 424 * MiB), SELI, SELG, ws + WS_PU, ws + WS_PV, P.ln_ffn_g, P.ln_ffn_b, STAT, P.ln_mix_g, P.ln_mix_b);
#endif
 REPBAR(7); } SEAM(7);
    if (IN(8)) for (int rep = 0; rep < NREP(8); ++rep) {
        pg8::Gemm g{HB, (const bf16*)(ws + WS_W_MIN), T, 768, 1024}; pg8::StaticOrder S; S.init(T, 768, F.G, (int)blockIdx.x);
        pg8::EpiF32 E{(float*)(ws + WS_MC), 768};
        pg8::gemm_phase<pg8::EpiF32, pg8::StaticOrder, true, true>(F.lds, g, S, E);
    REPBAR(8); } SEAM(8);
    if (IN(9)) for (int rep = 0; rep < NREP(9); ++rep) { mla_rows(F, P); REPBAR(9); } SEAM(9);
    if (IN(10)) for (int rep = 0; rep < NREP(10); ++rep) {
        { pg8::Gemm g{(const bf16*)(ws + WS_CQN), (const bf16*)(ws + WS_W_UQ), T, 1536, 384}; pg8::StaticOrder S; S.init(T, 1536, F.G, (int)blockIdx.x);
          pg8::EpiUq E{(bf16*)(ws + WS_MQ), P.pos, MLA_QS};
          pg8::gemm_phase<pg8::EpiUq, pg8::StaticOrder, true, true>(F.lds, g, S, E); }
        { pg8::Gemm g{(const bf16*)(ws + WS_CKVN), (const bf16*)(ws + WS_W_UKV), T, 2048, 256}; pg8::StaticOrder S; S.init(T, 2048, F.G, (int)blockIdx.x);
          pg8::EpiBf E{(bf16*)(ws + WS_MKV), 2048};
          pg8::gemm_phase<pg8::EpiBf, pg8::StaticOrder, true, true>(F.lds, g, S, E); }
    REPBAR(10); } SEAM(10);
    if (IN(11)) for (int rep = 0; rep < NREP(11); ++rep) {
        for (int u = F.vcu; u < 512; u += F.G) { const int bh = u >> 3, qb = u & 7;
            mla_unit(F.lds, (const bf16*)(ws + WS_MQ), (const bf16*)(ws + WS_MKV), (const bf16*)(ws + WS_KROPE), (bf16*)(ws + WS_MO), bh >> 3, bh & 7, qb); }
    REPBAR(11); } SEAM(11);
    if (IN(12)) for (int rep = 0; rep < NREP(12); ++rep) {
        pg8::Gemm g{(const bf16*)(ws + WS_MO), (const bf16*)(ws + WS_W_MOUT), T, 1024, 1024}; pg8::StaticOrder S; S.init(T, 1024, F.G, (int)blockIdx.x);
        pg8::EpiRes E{rep ? DUMH : P.H, rep ? DUMH : P.H, DN_ALPHA, ABL_MLA};
        pg8::gemm_phase<pg8::EpiRes, pg8::StaticOrder, true, true>(F.lds, g, S, E);
    REPBAR(12); } SEAM(12);
    if (IN(13)) for (int rep = 0; rep < NREP(13); ++rep) { ln_rows(F, P.H, rep ? DUMB : HB, P.ln_mix_g + DM, P.ln_mix_b + DM, STAT); REPBAR(13); } SEAM(13);
    if (IN(14)) for (int rep = 0; rep < NREP(14); ++rep) {
        pg8::Gemm g{HB, (const bf16*)(ws + WS_W_PQ) + (size_t)1024 * 2048, T, 2048, 1024}; pg8::StaticOrder S; S.init(T, 2048, F.G, (int)blockIdx.x);
        pg8::EpiBf E{(bf16*)(ws + WS_QP), 2048};
        pg8::gemm_phase<pg8::EpiBf, pg8::StaticOrder, true, true>(F.lds, g, S, E);
    REPBAR(14); } SEAM(14);
    if (IN(15)) for (int rep = 0; rep < NREP(15); ++rep) {
#ifdef TOPK_BRUTE
        for (int u = F.vcu; u < 256; u += F.G) topk_brute_unit(F.lds, (const bf16*)(ws + WS_QP), (const bf16*)(ws + WS_W_SK) + (size_t)8 * 2 * 128 * 128, SELI, SELG, u >> 3, u & 7);
#else
        for (int u = F.vcu, ui = 0; u < 512; u += F.G, ++ui) topk_unit(F.lds, (const bf16*)(ws + WS_QP), (const bf16*)(ws + WS_W_SK) + (size_t)8 * 2 * 128 * 128, SELI, SELG, u >> 3, u & 7);
#endif
    REPBAR(15); } SEAM(15);
    if (IN(16)) for (int rep = 0; rep < NREP(16); ++rep) { peer_gather<GV2>(F, rep ? DUMH : P.H, rep ? DUMB : HB, SELI, SELG, ws + WS_PU + (size_t)16384 * 1024, ws + WS_PV + (size_t)16384 * 1024, P.ln_ffn_g + DM, P.ln_ffn_b + DM, STAT, P.ln_mix_g + DM, P.ln_mix_b + DM); REPBAR(16); }
#undef IN
#undef SEAM
}

extern "C" void kernel_launch(void* const* d_in, const int* in_sizes, int n_in, void* d_out, int out_size, void* d_ws, size_t ws_size, hipStream_t stream) {
    static int grid = 0;
    if (grid == 0) {
        if (n_in != 21 || in_sizes[0] != T * DM || out_size != T * DM || ws_size < WS_END) { fprintf(stderr, "kernel_launch: unexpected shapes (n_in %d, in0 %d, out %d, ws %zu); nothing launched\n", n_in, n_in > 0 ? in_sizes[0] : -1, out_size, ws_size); grid = -1; return; }
        int dev = 0, cus = 0, per_cu = 0;
        if (hipGetDevice(&dev) != hipSuccess || hipDeviceGetAttribute(&cus, hipDeviceAttributeMultiprocessorCount, dev) != hipSuccess) { grid = -1; return; }
        if (hipFuncSetAttribute((const void*)mk_fwd, hipFuncAttributeMaxDynamicSharedMemorySize, LDS_BYTES) != hipSuccess) { fprintf(stderr, "kernel_launch: hipFuncSetAttribute failed\n"); grid = -1; return; }
        if (hipOccupancyMaxActiveBlocksPerMultiprocessor(&per_cu, (const void*)mk_fwd, NWAVES * 64, LDS_BYTES) != hipSuccess || per_cu < 1) { fprintf(stderr, "kernel_launch: occupancy query says %d blocks per CU\n", per_cu); }
        (void)hipGetLastError();
        grid = cus;
    }
    if (grid < 0) return;
    if (hipMemsetAsync((char*)d_ws + WS_CTL, 0, CTL_ZERO_BYTES, stream) != hipSuccess) return;
    Args a{};
    for (int i = 0; i < 21; ++i) a.in[i] = d_in[i];
    a.out = (float*)d_out; a.ws = (unsigned char*)d_ws;
#if MK_SINGLE
    a.ph_lo = 0; a.ph_hi = NPH;
    hipLaunchKernelGGL(mk_fwd, dim3(grid), dim3(NWAVES * 64), LDS_BYTES, stream, a);
#else
    for (int li = 0; li < NPH; ++li) { a.ph_lo = li; a.ph_hi = li + 1; hipLaunchKernelGGL(mk_fwd, dim3(grid), dim3(NWAVES * 64), LDS_BYTES, stream, a); }
#endif
}
```
